# Optimizing an MI355X kernel written in HIP

```python
import jax, jax.numpy as jnp
from jax import lax
import numpy as np

D_MODEL = 2048
BATCH = 4
SEQ = 4096
DEPTH = 1

CONV_WIDTH = 3
CONV_GROUPS = 8
D_CONV = D_MODEL // 2
HGRN_HEADS = 8
HGRN_DK = 128
HGRN_DV = (D_MODEL // 2) // HGRN_HEADS
D_HGRN_K = HGRN_HEADS * HGRN_DK
D_HGRN_V = HGRN_HEADS * HGRN_DV
CHUNK = 64
D_FF = ((8 * D_MODEL // 3 + 255) // 256) * 256
N_MOD = 6
EPS = 1e-6
SPLITS = (D_CONV, D_CONV, D_CONV, D_HGRN_K, D_HGRN_K, D_HGRN_V, D_HGRN_V, D_MODEL, D_MODEL)
D_IN = sum(SPLITS)

kernel_name = "hybrid_conv_hgrn2_gated_merge_block"


def rmsnorm(x, g):
    xf = x.astype(jnp.float32)
    y = xf * lax.rsqrt(jnp.mean(xf * xf, axis=-1, keepdims=True) + EPS)
    return (y * g.astype(jnp.float32)).astype(x.dtype)


def causal_depthwise_conv(u, w):
    s = u.shape[1]
    upad = jnp.pad(u, ((0, 0), (CONV_WIDTH - 1, 0), (0, 0)))
    y = w[0] * upad[:, 0:s]
    for k in range(1, CONV_WIDTH):
        y = y + w[k] * upad[:, k:k + s]
    return y


def to_chunks(t):
    b, s, h, d = t.shape
    return t.reshape(b, s // CHUNK, CHUNK, h, d).transpose(1, 0, 3, 2, 4)


def from_chunks(t):
    n, b, h, c, d = t.shape
    return t.transpose(1, 0, 3, 2, 4).reshape(b, n * c, h, d)


def hgrn2_chunked(q, k, v, log_f):
    qc, kc, vc = to_chunks(q), to_chunks(k), to_chunks(v)
    bc = jnp.cumsum(to_chunks(log_f), axis=3)
    causal = jnp.tril(jnp.ones((CHUNK, CHUNK), dtype=bool))[:, :, None]
    b_, h_ = q.shape[0], q.shape[2]
    s0 = jnp.zeros((b_, h_, HGRN_DK, HGRN_DV), jnp.float32)

    def step(state, xs):
        qi, ki, vi, bi = xs
        b_last = bi[:, :, -1:, :]
        o_inter = jnp.einsum('bhtk,bhkv->bhtv', qi * jnp.exp(bi), state)
        diff = bi[:, :, :, None, :] - bi[:, :, None, :, :]
        decay = jnp.exp(jnp.where(causal, diff, -jnp.inf))
        scores = jnp.einsum('bhtk,bhtsk,bhsk->bhts', qi, decay, ki)
        o_intra = jnp.einsum('bhts,bhsv->bhtv', scores, vi)
        new_state = (jnp.swapaxes(jnp.exp(b_last), -1, -2) * state
                     + jnp.einsum('bhsk,bhsv->bhkv', ki * jnp.exp(b_last - bi), vi))
        return new_state, o_inter + o_intra

    _, o = lax.scan(step, s0, (qc, kc, vc, bc))
    return from_chunks(o)


def setup_inputs(seed: int = 0) -> dict:
    key = jax.random.key(seed)
    ks = jax.random.split(key, 20)

    def nrm(k, shape, fan_in):
        return jax.random.normal(k, shape, jnp.float32) * (fan_in ** -0.5)

    def gain(k, shape):
        return 1.0 + 0.02 * jax.random.normal(k, shape, jnp.float32)

    return {
        "x": jax.random.normal(ks[0], (BATCH, SEQ, D_MODEL), jnp.float32),
        "c": jax.random.normal(ks[1], (BATCH, D_MODEL), jnp.float32),
        "w_ada": nrm(ks[2], (DEPTH, D_MODEL, N_MOD * D_MODEL), D_MODEL) * 0.5,
        "b_ada": 0.02 * jax.random.normal(ks[3], (DEPTH, N_MOD * D_MODEL), jnp.float32),
        "norm_mix_g": gain(ks[4], (DEPTH, D_MODEL)),
        "w_in": nrm(ks[5], (DEPTH, D_MODEL, D_IN), D_MODEL),
        "conv_w": nrm(ks[6], (DEPTH, CONV_WIDTH, D_CONV), CONV_WIDTH),
        "lb_param": jax.random.normal(ks[7], (DEPTH + 1, D_HGRN_K), jnp.float32),
        "gnorm_g": gain(ks[8], (DEPTH, HGRN_DV)),
        "w_conv_out": nrm(ks[9], (DEPTH, D_CONV, D_MODEL), D_CONV),
        "w_hgrn_out": nrm(ks[10], (DEPTH, D_HGRN_V, D_MODEL), D_HGRN_V),
        "w_o": nrm(ks[11], (DEPTH, D_MODEL, D_MODEL), D_MODEL),
        "norm_ffn_g": gain(ks[12], (DEPTH, D_MODEL)),
        "w_ffn_gate": nrm(ks[13], (DEPTH, D_MODEL, D_FF), D_MODEL),
        "w_ffn_up": nrm(ks[14], (DEPTH, D_MODEL, D_FF), D_MODEL),
        "w_ffn_down": nrm(ks[15], (DEPTH, D_FF, D_MODEL), D_FF),
        "norm_final_g": gain(ks[16], (D_MODEL,)),
    }


def reference(x, c, w_ada, b_ada, norm_mix_g, w_in, conv_w, lb_param, gnorm_g,
              w_conv_out, w_hgrn_out, w_o, norm_ffn_g, w_ffn_gate, w_ffn_up, w_ffn_down,
              norm_final_g):
    b, s, _ = x.shape
    lb_all = jnp.cumsum(jax.nn.softmax(lb_param.astype(jnp.float32), axis=0), axis=0)
    split_idx = list(np.cumsum(SPLITS)[:-1])
    c_act = jax.nn.silu(c)

    for l in range(DEPTH):
        mod = c_act @ w_ada[l] + b_ada[l]
        sh_m, sc_m, gt_m, sh_f, sc_f, gt_f = [m[:, None, :] for m in jnp.split(mod, N_MOD, axis=-1)]

        h = rmsnorm(x, norm_mix_g[l]) * (1.0 + sc_m) + sh_m
        proj = h @ w_in[l]
        a_b, a_c, a_x, q, f_logit, i_in, g_out, gate_a, gate_b = jnp.split(proj, split_idx, axis=-1)

        y_a = (a_b * causal_depthwise_conv(a_c * a_x, conv_w[l])) @ w_conv_out[l]

        lb = lb_all[l]
        f = lb + (1.0 - lb) * jax.nn.sigmoid(f_logit.astype(jnp.float32))
        qh = jax.nn.silu(q.astype(jnp.float32)).reshape(b, s, HGRN_HEADS, HGRN_DK)
        kh = (1.0 - f).reshape(b, s, HGRN_HEADS, HGRN_DK)
        log_f = jnp.log(f).reshape(b, s, HGRN_HEADS, HGRN_DK)
        vh = i_in.astype(jnp.float32).reshape(b, s, HGRN_HEADS, HGRN_DV)
        o = hgrn2_chunked(qh, kh, vh, log_f)
        o = rmsnorm(o, gnorm_g[l]) * jax.nn.silu(g_out.astype(jnp.float32)).reshape(b, s, HGRN_HEADS, HGRN_DV)
        y_b = o.reshape(b, s, D_HGRN_V).astype(x.dtype) @ w_hgrn_out[l]

        merged = jax.nn.sigmoid(gate_a) * y_a + jax.nn.sigmoid(gate_b) * y_b
        x = x + gt_m * (merged @ w_o[l])

        h2 = rmsnorm(x, norm_ffn_g[l]) * (1.0 + sc_f) + sh_f
        ff = (jax.nn.silu(h2 @ w_ffn_gate[l]) * (h2 @ w_ffn_up[l])) @ w_ffn_down[l]
        x = x + gt_f * ff

    return rmsnorm(x, norm_final_g)
```

```cpp
#include <hip/hip_runtime.h>
#include <hip/hip_cooperative_groups.h>
#include <cstdio>
#include <cstdint>
namespace cg = cooperative_groups;

#ifndef MK_N_LAUNCHES
#define MK_N_LAUNCHES 1
#endif

#ifndef PROBE_DUP
#define PROBE_DUP -1
#endif

#define LAS __attribute__((address_space(3)))
typedef unsigned short bf16_t;
typedef short bf16x8 __attribute__((ext_vector_type(8)));
typedef float f32x4 __attribute__((ext_vector_type(4)));
typedef float f32x2 __attribute__((ext_vector_type(2)));
typedef unsigned u32x4 __attribute__((ext_vector_type(4)));
typedef unsigned u32x2 __attribute__((ext_vector_type(2)));
typedef unsigned short u16x4 __attribute__((ext_vector_type(4)));
typedef int i32x8 __attribute__((ext_vector_type(8)));
typedef int i32x4_ __attribute__((ext_vector_type(4)));

constexpr int D = 2048, BATCH = 4, SEQ = 4096, M = BATCH * SEQ;
constexpr int DC = 1024, HK = 1024, HV = 1024, NH = 8, CHUNK = 64, NCHUNK = SEQ / CHUNK;
constexpr int D_IN = 11264, D_FF = 5632, NMOD = 6 * D;
constexpr float EPS = 1e-6f;

constexpr size_t MiB = 1u << 20;
constexpr size_t WS_CTL = 0;
constexpr size_t CTL_MOD = 65536, CTL_RSS1 = 262144, CTL_RSS2 = 327680, CTL_ZERO_BYTES = 393216;
constexpr size_t CTL_LB = 393216, CTL_BIASGU = 397312;
constexpr int CW_BAR = 4096, CW_PANEL = 8192, CW_HEAD = 12288, CW_MODDONE = 14336, CW_XCCTAB = 14400;
constexpr size_t WS_WT_IN = 2 * MiB, WS_WT_GU = 46 * MiB, WS_WT_D = 90 * MiB, WS_WT_M = 112 * MiB, WS_WT_O = 120 * MiB;
constexpr size_t WS_H = 128 * MiB;
constexpr size_t WS_AB = 192 * MiB, WS_U = 224 * MiB, WS_Q = 256 * MiB, WS_V = 288 * MiB, WS_G = 320 * MiB, WS_LOGF = 352 * MiB, WS_ZO = 416 * MiB;
constexpr size_t WS_ACT = 192 * MiB;
constexpr size_t WS_X1 = 368 * MiB;
constexpr size_t WS_WT8 = 496 * MiB;
constexpr size_t WS_H8 = 416 * MiB;
constexpr size_t WS_END = 512 * MiB;

__device__ __forceinline__ float bf2f(unsigned h) { return __uint_as_float(h << 16); }
__device__ __forceinline__ unsigned cvt_pk_bf16(float lo, float hi) { unsigned r; asm volatile("v_cvt_pk_bf16_f32 %0, %1, %2" : "=v"(r) : "v"(lo), "v"(hi)); return r; }
__device__ __forceinline__ unsigned pack4_fp8(float a, float b, float c, float d) {
    a = __builtin_amdgcn_fmed3f(a, -448.f, 448.f); b = __builtin_amdgcn_fmed3f(b, -448.f, 448.f); c = __builtin_amdgcn_fmed3f(c, -448.f, 448.f); d = __builtin_amdgcn_fmed3f(d, -448.f, 448.f);
    int p = 0; p = __builtin_amdgcn_cvt_pk_fp8_f32(a, b, p, false); p = __builtin_amdgcn_cvt_pk_fp8_f32(c, d, p, true); return (unsigned)p; }
__device__ __forceinline__ float fast_rcp(float x) { return __builtin_amdgcn_rcpf(x); }
__device__ __forceinline__ float fast_exp(float x) { return __builtin_amdgcn_exp2f(x * 1.44269504089f); }
__device__ __forceinline__ float fast_log(float x) { return __builtin_amdgcn_logf(x) * 0.69314718056f; }
__device__ __forceinline__ float sigmoidf_(float x) { return fast_rcp(1.0f + fast_exp(-x)); }
__device__ __forceinline__ float siluf_(float x) { return x * sigmoidf_(x); }
__device__ __forceinline__ float wave_sum(float v) {
#pragma unroll
    for (int o = 1; o < 64; o <<= 1) v += __shfl_xor(v, o);
    return v;
}

namespace pg8 {
constexpr int BM = 256, BK = 64, HALF = 128, HTB = HALF * BK * 2, STAGE_BYTES = 8 * HTB, NXCD = 8, WGM = 8;
__host__ __device__ __forceinline__ int lds_byte(int r, int c) { return r * 128 + ((((c >> 3) ^ (r >> 1)) & 7) << 4) + (c & 7) * 2; }
__host__ __device__ __forceinline__ void stage_rc(int b, int& R, int& C) { R = b >> 7; C = ((((b >> 4) & 7) ^ (R >> 1)) & 7) * 8; }
__host__ __device__ __forceinline__ int perm32(int rho) { const int n = rho >> 4, i = rho & 15; return 8 * (i >> 2) + 4 * n + (i & 3); }

struct Unit { int pm, pn; };
struct Gemm { const bf16_t* A; const bf16_t* Bt; int M, N, K; };

struct StaticOrder {
    int nM, nN, nwg, G, c;
    __host__ __device__ void init(int M_, int N_, int G_, int c_) { nM = M_ / BM; nN = N_ / BM; nwg = nM * nN; G = G_; c = c_; }
    __host__ __device__ bool next(int i, Unit& u) const {
        const long L = (long)i * G + c; if (L >= nwg) return false;
        if (nN == 16 && nM == 64 && G == 256) {
            const int x = c & 7, j = c >> 3; u.pm = 8 * x + 4 * (i & 1) + (j & 3); u.pn = 8 * (i >> 1) + (j >> 2); return true; }
        if (nN == 28 && nM == 64 && G == 256) {
            const int x = c & 7, j = c >> 3;
            if (i < 6) { u.pm = 8 * x + 4 * (i & 1) + (j & 3); u.pn = 8 * (i >> 1) + (j >> 2); } else { u.pm = 8 * x + (j & 7); u.pn = 24 + (j >> 3); }
            return true; }
        if (nN == 44 && nM == 64 && G == 256) {
            const int x = c & 7, j = c >> 3;
            if (i < 10) { u.pm = 8 * x + 4 * (i & 1) + (j & 3); u.pn = 8 * (i >> 1) + (j >> 2); } else { u.pm = 8 * x + (j & 7); u.pn = 40 + (j >> 3); }
            return true; }
        if (nN == 8 && nM == 64 && G == 256) {
            const int x = c & 7, j = c >> 3; u.pm = 8 * x + 4 * i + (j & 3); u.pn = j >> 2; return true; }
        int wgid = (int)L; { const int q = nwg / NXCD, r = nwg % NXCD, xcd = wgid % NXCD, off = wgid / NXCD; wgid = (xcd < r ? xcd * (q + 1) : r * (q + 1) + (xcd - r) * q) + off; }
        const int nig = WGM * nN, gid = wgid / nig, fm = gid * WGM, gsz = (nM - fm) < WGM ? (nM - fm) : WGM;
        u.pm = fm + ((wgid % nig) % gsz); u.pn = (wgid % nig) / gsz; return true;
    }
};

template <class Epi, bool ALIGN_EPI, bool SP2, bool FP8 = false>
__device__ __forceinline__ void gemm_phase(LAS unsigned char* lds, const Gemm g, const StaticOrder& S, const Epi& E) {
    int tid_ = threadIdx.x; asm volatile("" : "+v"(tid_));
    const int tid = tid_, wid = __builtin_amdgcn_readfirstlane(tid >> 6), lane = tid & 63, wr = wid >> 2, wc = wid & 3, fr = lane & 15, fq = lane >> 4;
    const int K = g.K, nt = K / BK;
    unsigned voffA, voffB;
    { int R, C; stage_rc(tid * 16, R, C); const int Rb = (R & ~31) + perm32(R & 31);
        voffA = (unsigned)(R * K + C) * 2u; voffB = (unsigned)(Rb * K + C) * 2u; }
    const size_t qstep = (size_t)64 * K * 2;
    const size_t kstep = (size_t)(BK * 2);
    const size_t hstep = (size_t)HALF * K * 2;
    const size_t tstep = 2 * hstep;
    const unsigned ldsw = (unsigned)wid * 1024u;
    const int aoffk[2] = {lds_byte(wr * 64 + fr, fq * 8), lds_byte(wr * 64 + fr, 32 + fq * 8)}, boffk[2] = {lds_byte(wc * 32 + fr, fq * 8), lds_byte(wc * 32 + fr, 32 + fq * 8)};
#define PG8_SA(b, h) (((b) * 2 + (h)) * HTB)
#define PG8_SB(b, h) ((4 + (b) * 2 + (h)) * HTB)
#define PG8_STAGE(bufoff, gbase, voff) do { _Pragma("unroll") for (int _i = 0; _i < 2; ++_i) \
        __builtin_amdgcn_global_load_lds((const unsigned*)((const char*)(gbase) + _i * qstep + (voff)), (LAS unsigned*)(lds + (bufoff) + ldsw + _i * 8192), 16, 0, 0); } while (0)
#define PG8_LDA(dst, b, h) do { if constexpr (FP8) { _Pragma("unroll") for (int m = 0; m < 4; ++m) dst##8[m] = __builtin_shufflevector(*(const LAS i32x4_*)(lds + PG8_SA(b, h) + aoffk[0] + m * 2048), *(const LAS i32x4_*)(lds + PG8_SA(b, h) + aoffk[1] + m * 2048), 0, 1, 2, 3, 4, 5, 6, 7); } \
        else { _Pragma("unroll") for (int m = 0; m < 4; ++m) _Pragma("unroll") for (int k = 0; k < 2; ++k) dst[m][k] = *(const LAS bf16x8*)(lds + PG8_SA(b, h) + aoffk[k] + m * 2048); } } while (0)
#define PG8_LDB(dst, b, h) do { if constexpr (FP8) { _Pragma("unroll") for (int n = 0; n < 2; ++n) dst##8[n] = __builtin_shufflevector(*(const LAS i32x4_*)(lds + PG8_SB(b, h) + boffk[0] + n * 2048), *(const LAS i32x4_*)(lds + PG8_SB(b, h) + boffk[1] + n * 2048), 0, 1, 2, 3, 4, 5, 6, 7); } \
        else { _Pragma("unroll") for (int n = 0; n < 2; ++n) _Pragma("unroll") for (int k = 0; k < 2; ++k) dst[n][k] = *(const LAS bf16x8*)(lds + PG8_SB(b, h) + boffk[k] + n * 2048); } } while (0)
#define PG8_MMA(ai, bj, At, Bt) do { __builtin_amdgcn_s_setprio(1); \
        if constexpr (FP8) { _Pragma("unroll") for (int m = 0; m < 4; ++m) _Pragma("unroll") for (int n = 0; n < 2; ++n) \
            asm volatile("v_mfma_scale_f32_16x16x128_f8f6f4 %0, %1, %2, %0, %3, %3 op_sel_hi:[0,0,0]" : "+v"(acc[ai][bj][m][n]) : "v"(Bt##8[n]), "v"(At##8[m]), "v"(one_scale)); } \
        else { _Pragma("unroll") for (int m = 0; m < 4; ++m) _Pragma("unroll") for (int n = 0; n < 2; ++n) _Pragma("unroll") for (int k = 0; k < 2; ++k) \
            acc[ai][bj][m][n] = __builtin_amdgcn_mfma_f32_16x16x32_bf16(Bt[n][k], At[m][k], acc[ai][bj][m][n], 0, 0, 0); } \
        __builtin_amdgcn_s_setprio(0); } while (0)
#define PG8_WAIT_V(n) asm volatile("s_waitcnt vmcnt(" #n ")" ::: "memory")
#define PG8_WAIT_L(n) asm volatile("s_waitcnt lgkmcnt(" #n ")" ::: "memory")
#define PG8_BAR __builtin_amdgcn_s_barrier()
#define PG8_SCHED __builtin_amdgcn_sched_barrier(0)
    Unit cur, nxt; int ui = 0;
    if (!S.next(0, cur)) return;
    f32x4 acc[2][2][4][2];
#pragma unroll
    for (int a = 0; a < 2; ++a)
#pragma unroll
        for (int b = 0; b < 2; ++b)
#pragma unroll
            for (int m = 0; m < 4; ++m)
#pragma unroll
                for (int n = 0; n < 2; ++n) acc[a][b][m][n] = (f32x4){0.f, 0.f, 0.f, 0.f};
    const int one_scale = 0x7f7f7f7f;
    bf16x8 At[4][2], B0[2][2], B1[2][2]; i32x8 At8[4], B08[2], B18[2];
    const char* cA = (const char*)g.A + (size_t)cur.pm * tstep; const char* cB = (const char*)g.Bt + (size_t)cur.pn * tstep;
    if constexpr (SP2) {
        PG8_STAGE(PG8_SB(0, 0), cB, voffB); PG8_STAGE(PG8_SB(0, 1), cB + hstep, voffB); PG8_STAGE(PG8_SA(0, 0), cA, voffA); PG8_STAGE(PG8_SA(0, 1), cA + hstep, voffA);
        if (wr == 1) PG8_BAR;
        PG8_WAIT_V(2); PG8_BAR;
        PG8_STAGE(PG8_SB(1, 0), cB + kstep, voffB); PG8_STAGE(PG8_SA(1, 0), cA + kstep, voffA); PG8_STAGE(PG8_SB(1, 1), cB + hstep + kstep, voffB);
        PG8_WAIT_V(6); PG8_BAR;
    } else {
        PG8_STAGE(PG8_SB(0, 0), cB, voffB); PG8_STAGE(PG8_SA(0, 0), cA, voffA); PG8_STAGE(PG8_SB(0, 1), cB + hstep, voffB); PG8_STAGE(PG8_SA(0, 1), cA + hstep, voffA);
        if (wr == 1) PG8_BAR;
        PG8_WAIT_V(4); PG8_BAR;
        PG8_STAGE(PG8_SB(1, 0), cB + kstep, voffB); PG8_STAGE(PG8_SA(1, 0), cA + kstep, voffA); PG8_STAGE(PG8_SB(1, 1), cB + hstep + kstep, voffB);
        PG8_WAIT_V(6); PG8_BAR;
    }
    for (;;) {
        const bool has_next = S.next(ui + 1, nxt);
        const char* nA = has_next ? (const char*)g.A + (size_t)nxt.pm * tstep : cA; const char* nB = has_next ? (const char*)g.Bt + (size_t)nxt.pn * tstep : cB;
        for (int t = 0; t < nt; t += 2) {
            const bool last = (t == nt - 2);
            const char* a1 = cA + (size_t)(t + 1) * kstep;
            const char* a2 = last ? nA : cA + (size_t)(t + 2) * kstep; const char* b2 = last ? nB : cB + (size_t)(t + 2) * kstep;
            const char* a3 = a2 + kstep; const char* b3 = b2 + kstep;
            if constexpr (Epi::MIDK) { if (t == nt / 2) { int tl = threadIdx.x; asm volatile("" : "+v"(tl)); const int le = tl & 63; E.mid(acc, cur, wr, wc, le & 15, le >> 4); } }
            if constexpr (SP2) {
            PG8_LDB(B0, 0, 0); PG8_LDB(B1, 0, 1); PG8_SCHED; PG8_LDA(At, 0, 0); PG8_STAGE(PG8_SA(1, 1), a1 + hstep, voffA);
            PG8_WAIT_V(8); PG8_WAIT_L(0); PG8_BAR; PG8_MMA(0, 0, At, B0); PG8_MMA(0, 1, At, B1); PG8_BAR; PG8_SCHED;
            PG8_LDA(At, 0, 1); PG8_STAGE(PG8_SB(0, 0), b2, voffB); PG8_STAGE(PG8_SB(0, 1), b2 + hstep, voffB); PG8_STAGE(PG8_SA(0, 0), a2, voffA);
            PG8_WAIT_V(8); PG8_WAIT_L(0); PG8_BAR; PG8_MMA(1, 0, At, B0); PG8_MMA(1, 1, At, B1); PG8_BAR; PG8_SCHED;
            PG8_LDB(B0, 1, 0); PG8_LDB(B1, 1, 1); PG8_SCHED; PG8_LDA(At, 1, 0); PG8_STAGE(PG8_SA(0, 1), a2 + hstep, voffA);
            PG8_WAIT_V(8); PG8_WAIT_L(0); PG8_BAR; PG8_MMA(0, 0, At, B0); PG8_MMA(0, 1, At, B1); PG8_BAR; PG8_SCHED;
            PG8_LDA(At, 1, 1); PG8_STAGE(PG8_SB(1, 0), b3, voffB); PG8_STAGE(PG8_SB(1, 1), b3 + hstep, voffB); PG8_STAGE(PG8_SA(1, 0), a3, voffA);
            PG8_WAIT_V(8); PG8_WAIT_L(0); PG8_BAR; PG8_MMA(1, 0, At, B0); PG8_MMA(1, 1, At, B1); PG8_BAR; PG8_SCHED;
            } else {
            PG8_LDB(B0, 0, 0); PG8_SCHED; PG8_LDA(At, 0, 0); PG8_STAGE(PG8_SA(1, 1), a1 + hstep, voffA);
            PG8_WAIT_L(8); PG8_BAR; PG8_WAIT_L(0); PG8_MMA(0, 0, At, B0); PG8_BAR; PG8_SCHED;
            PG8_LDB(B1, 0, 1); PG8_STAGE(PG8_SB(0, 0), b2, voffB);
            PG8_BAR; PG8_WAIT_L(0); PG8_MMA(0, 1, At, B1); PG8_BAR;
            PG8_LDA(At, 0, 1); PG8_STAGE(PG8_SA(0, 0), a2, voffA);
            PG8_BAR; PG8_WAIT_L(0); PG8_MMA(1, 0, At, B0); PG8_BAR; PG8_SCHED;
            PG8_STAGE(PG8_SB(0, 1), b2 + hstep, voffB);
            PG8_WAIT_V(6); PG8_BAR; PG8_MMA(1, 1, At, B1); PG8_BAR;
            PG8_LDB(B0, 1, 0); PG8_SCHED; PG8_LDA(At, 1, 0); PG8_STAGE(PG8_SA(0, 1), a2 + hstep, voffA);
            PG8_WAIT_L(8); PG8_BAR; PG8_WAIT_L(0); PG8_MMA(0, 0, At, B0); PG8_BAR; PG8_SCHED;
            PG8_LDB(B1, 1, 1); PG8_STAGE(PG8_SB(1, 0), b3, voffB);
            PG8_BAR; PG8_WAIT_L(0); PG8_MMA(0, 1, At, B1); PG8_BAR;
            PG8_LDA(At, 1, 1); PG8_STAGE(PG8_SA(1, 0), a3, voffA);
            PG8_BAR; PG8_WAIT_L(0); PG8_MMA(1, 0, At, B0); PG8_BAR; PG8_SCHED;
            PG8_STAGE(PG8_SB(1, 1), b3 + hstep, voffB);
            PG8_WAIT_V(6); PG8_BAR; PG8_MMA(1, 1, At, B1); PG8_BAR;
            }
        }
        if constexpr (ALIGN_EPI) { if (wr == 0) PG8_BAR; }
        if constexpr (FP8) asm volatile("s_nop 15\n\ts_nop 15" ::: "memory");
        { int tl = threadIdx.x; asm volatile("" : "+v"(tl));
          const int le = tl & 63; E(acc, cur, wr, wc, le & 15, le >> 4); }
        if (!has_next) break;
#pragma unroll
        for (int a = 0; a < 2; ++a)
#pragma unroll
            for (int b = 0; b < 2; ++b)
#pragma unroll
                for (int m = 0; m < 4; ++m)
#pragma unroll
                    for (int n = 0; n < 2; ++n) acc[a][b][m][n] = (f32x4){0.f, 0.f, 0.f, 0.f};
        cur = nxt; cA = nA; cB = nB; ++ui;
        if constexpr (ALIGN_EPI) { if (wr == 1) PG8_BAR; }
    }
    PG8_WAIT_V(0);
    if constexpr (!ALIGN_EPI) { if (wr == 0) PG8_BAR; }
    PG8_BAR;
#undef PG8_SA
#undef PG8_SB
#undef PG8_STAGE
#undef PG8_LDA
#undef PG8_LDB
#undef PG8_MMA
#undef PG8_WAIT_V
#undef PG8_WAIT_L
#undef PG8_BAR
#undef PG8_SCHED
}

typedef f32x4 Acc[2][2][4][2];
__device__ __forceinline__ u32x4 pack8(const f32x4 v0, const f32x4 v1) {
    u32x4 w; w.x = cvt_pk_bf16(v0[0], v0[1]); w.y = cvt_pk_bf16(v0[2], v0[3]); w.z = cvt_pk_bf16(v1[0], v1[1]); w.w = cvt_pk_bf16(v1[2], v1[3]); return w;
}
__device__ __forceinline__ void unpack8(const u32x4 w, f32x4& v0, f32x4& v1) {
    v0[0] = __uint_as_float(w.x << 16); v0[1] = __uint_as_float(w.x & 0xffff0000u); v0[2] = __uint_as_float(w.y << 16); v0[3] = __uint_as_float(w.y & 0xffff0000u);
    v1[0] = __uint_as_float(w.z << 16); v1[1] = __uint_as_float(w.z & 0xffff0000u); v1[2] = __uint_as_float(w.w << 16); v1[3] = __uint_as_float(w.w & 0xffff0000u);
}

template <bool GATES> struct EpiIn {
    static constexpr bool MIDK = false;
    bf16_t *AB, *U, *Q, *V, *G, *R, *GB; float* LOGF; const float* lb; int pn_off; float ascale;
    __device__ __forceinline__ void mid(Acc&, const Unit&, int, int, int, int) const {}
    __device__ __forceinline__ void operator()(Acc& acc, const Unit& u, int wr, int wc, int fr, int fq) const {
        asm volatile("" : "+v"(fr), "+v"(fq));
        const int pn = u.pn + pn_off; const int row0 = u.pm * BM + wr * 64 + fr; const int cw = wc * 32 + 8 * fq;
        if (GATES) {
            const int col = 128 * pn + cw;
#pragma unroll
            for (int ai = 0; ai < 2; ++ai)
#pragma unroll
                for (int m = 0; m < 4; ++m) { const size_t o = (size_t)(row0 + ai * HALF + m * 16) * D + col;
                    f32x4 r[2], gbv[2];
#pragma unroll
                    for (int n = 0; n < 2; ++n)
#pragma unroll
                        for (int j = 0; j < 4; ++j) { float a = acc[ai][0][m][n][j] * ascale, b = acc[ai][1][m][n][j] * ascale;
                            a = fminf(fmaxf(a, -30.f), 30.f); b = fminf(fmaxf(b, -30.f), 30.f);
                            const float ea = 1.0f + fast_exp(-a), eb = 1.0f + fast_exp(-b); const float ia = fast_rcp(ea), ib = fast_rcp(eb);
                            r[n][j] = eb * ia; gbv[n][j] = ib; }
                    *(u32x4*)(R + o) = pack8(r[0], r[1]); *(u32x4*)(GB + o) = pack8(gbv[0], gbv[1]); }
        } else if (!GATES && pn >= 20 && pn < 28) {
            const int col = 128 * (pn - 20) + cw;
#pragma unroll
            for (int ai = 0; ai < 2; ++ai)
#pragma unroll
                for (int m = 0; m < 4; ++m) { const size_t o = (size_t)(row0 + ai * HALF + m * 16) * DC + col;
                    *(u32x4*)(U + o) = pack8(acc[ai][0][m][0] * acc[ai][1][m][0], acc[ai][0][m][1] * acc[ai][1][m][1]); }
        } else if (!GATES && pn >= 36 && pn < 40) {
            const int colt = 256 * (pn - 36) + cw;
#pragma unroll
            for (int bj = 0; bj < 2; ++bj) { const int col = colt + bj * HALF;
                const f32x4 l0 = *(const f32x4*)(lb + col), l1 = *(const f32x4*)(lb + col + 4);
#pragma unroll
                for (int ai = 0; ai < 2; ++ai)
#pragma unroll
                    for (int m = 0; m < 4; ++m) { float* o = LOGF + (size_t)(row0 + ai * HALF + m * 16) * HK + col; f32x4 y0, y1;
#pragma unroll
                        for (int j = 0; j < 4; ++j) { y0[j] = fast_log(l0[j] + (1.0f - l0[j]) * sigmoidf_(acc[ai][bj][m][0][j])); y1[j] = fast_log(l1[j] + (1.0f - l1[j]) * sigmoidf_(acc[ai][bj][m][1][j])); }
                        *(f32x4*)o = y0; *(f32x4*)(o + 4) = y1; } }
        } else if (!GATES) {
            bf16_t* dst; int colt; bool act;
            if (pn < 20) { dst = AB; colt = 256 * (pn - 16); act = false; }
            else if (pn < 32) { dst = Q; colt = 256 * (pn - 28); act = true; }
            else if (pn < 36) { dst = G; colt = 256 * (pn - 32); act = true; }
            else { dst = V; colt = 256 * (pn - 40); act = false; }
            colt += cw;
#pragma unroll
            for (int ai = 0; ai < 2; ++ai)
#pragma unroll
                for (int m = 0; m < 4; ++m) { bf16_t* rowp = dst + (size_t)(row0 + ai * HALF + m * 16) * 1024 + colt;
#pragma unroll
                    for (int bj = 0; bj < 2; ++bj) { f32x4 v0 = acc[ai][bj][m][0], v1 = acc[ai][bj][m][1];
                        if (act) {
#pragma unroll
                            for (int j = 0; j < 4; ++j) { v0[j] = siluf_(v0[j]); v1[j] = siluf_(v1[j]); } }
                        *(u32x4*)(rowp + bj * HALF) = pack8(v0, v1); } }
        }
    }
};

struct EpiMerge {
    static constexpr bool MIDK = true;
    const bf16_t *R, *GB; bf16_t* MG;
    __device__ __forceinline__ void mid(Acc& acc, const Unit& u, int wr, int wc, int fr, int fq) const {
        asm volatile("" : "+v"(fr), "+v"(fq));
        const int row0 = u.pm * BM + wr * 64 + fr, col0 = u.pn * BM + wc * 32 + 8 * fq;
#pragma unroll
        for (int ai = 0; ai < 2; ++ai)
#pragma unroll
            for (int m = 0; m < 4; ++m) { const bf16_t* rp = R + (size_t)(row0 + ai * HALF + m * 16) * D + col0;
#pragma unroll
                for (int bj = 0; bj < 2; ++bj) { const u32x4 w = *(const u32x4*)(rp + bj * HALF); f32x4 r0, r1; unpack8(w, r0, r1);
                    acc[ai][bj][m][0] *= r0; acc[ai][bj][m][1] *= r1; } }
    }
    __device__ __forceinline__ void operator()(Acc& acc, const Unit& u, int wr, int wc, int fr, int fq) const {
        asm volatile("" : "+v"(fr), "+v"(fq));
        const int row0 = u.pm * BM + wr * 64 + fr, col0 = u.pn * BM + wc * 32 + 8 * fq;
        u32x4 gb[2][2];
        { const size_t o = (size_t)row0 * D + col0; gb[0][0] = *(const u32x4*)(GB + o); gb[0][1] = *(const u32x4*)(GB + o + HALF); }
#pragma unroll
        for (int it = 0; it < 8; ++it) { const int ai = it >> 2, m = it & 3; const size_t o = (size_t)(row0 + ai * HALF + m * 16) * D + col0;
            if (it < 7) { const size_t o2 = (size_t)(row0 + ((it + 1) >> 2) * HALF + ((it + 1) & 3) * 16) * D + col0; gb[(it + 1) & 1][0] = *(const u32x4*)(GB + o2); gb[(it + 1) & 1][1] = *(const u32x4*)(GB + o2 + HALF); }
#pragma unroll
            for (int bj = 0; bj < 2; ++bj) { f32x4 g0, g1; unpack8(gb[it & 1][bj], g0, g1);
                *(u32x4*)(MG + o + bj * HALF) = pack8(acc[ai][bj][m][0] * g0, acc[ai][bj][m][1] * g1); } }
    }
};

struct EpiWo {
    static constexpr bool MIDK = false;
    const float* x; const float* mod; const float* gffn; bf16_t* X1; bf16_t* X1S; float* rss; float amul;
    __device__ __forceinline__ void mid(Acc&, const Unit&, int, int, int, int) const {}
    __device__ __forceinline__ void operator()(Acc& acc, const Unit& u, int wr, int wc, int fr, int fq) const {
        asm volatile("" : "+v"(fr), "+v"(fq));
        const int row0 = u.pm * BM + wr * 64 + fr, col0 = u.pn * BM + wc * 32 + 8 * fq; const int b = u.pm >> 4;
        const float* mb = mod + (size_t)b * NMOD;
        f32x4 gt[2][2], gm[2][2];
#pragma unroll
        for (int bj = 0; bj < 2; ++bj)
#pragma unroll
            for (int n = 0; n < 2; ++n) { const int c = col0 + bj * HALF + 4 * n; gt[bj][n] = *(const f32x4*)(mb + 2 * D + c);
                const f32x4 s = *(const f32x4*)(mb + 4 * D + c), gg = *(const f32x4*)(gffn + c); gm[bj][n] = gg * (s + 1.0f); }
        f32x4 xb[2][4];
        { const size_t o = (size_t)row0 * D + col0;
#pragma unroll
          for (int q = 0; q < 4; ++q) xb[0][q] = *(const f32x4*)(x + o + (q >> 1) * HALF + 4 * (q & 1)); }
#pragma unroll
        for (int it = 0; it < 8; ++it) { const int ai = it >> 2, m = it & 3; const int row = row0 + ai * HALF + m * 16; const size_t o = (size_t)row * D + col0; float ss = 0.f;
            if (it < 7) { const size_t o2 = (size_t)(row0 + ((it + 1) >> 2) * HALF + ((it + 1) & 3) * 16) * D + col0;
#pragma unroll
                for (int q = 0; q < 4; ++q) xb[(it + 1) & 1][q] = *(const f32x4*)(x + o2 + (q >> 1) * HALF + 4 * (q & 1)); }
#pragma unroll
            for (int bj = 0; bj < 2; ++bj) { f32x4 v[2];
#pragma unroll
                for (int n = 0; n < 2; ++n) { v[n] = xb[it & 1][bj * 2 + n] + gt[bj][n] * acc[ai][bj][m][n];
                    ss += (v[n][0] * v[n][0] + v[n][1] * v[n][1]) + (v[n][2] * v[n][2] + v[n][3] * v[n][3]); }
                *(u32x4*)(X1 + o + bj * HALF) = pack8(v[0], v[1]);
                *(u32x4*)(X1S + o + bj * HALF) = pack8(v[0] * gm[bj][0], v[1] * gm[bj][1]); }
            ss += __shfl_xor(ss, 16); ss += __shfl_xor(ss, 32);
            if (fq == 0) atomicAdd(rss + row, ss * amul); }
    }
};

struct EpiFfn {
    static constexpr bool MIDK = false;
    const float* rss; const float* bias; bf16_t* ACT;
    __device__ __forceinline__ void mid(Acc&, const Unit&, int, int, int, int) const {}
    __device__ __forceinline__ void operator()(Acc& acc, const Unit& u, int wr, int wc, int fr, int fq) const {
        asm volatile("" : "+v"(fr), "+v"(fq));
        const int row0 = u.pm * BM + wr * 64 + fr, cw = wc * 32 + 8 * fq; const int b = u.pm >> 4;
        const float* bb = bias + (size_t)b * (2 * D_FF) + u.pn * BM + cw;
        f32x4 bg[2], bu[2];
#pragma unroll
        for (int n = 0; n < 2; ++n) { bg[n] = *(const f32x4*)(bb + 4 * n); bu[n] = *(const f32x4*)(bb + HALF + 4 * n); }
        float rs[8];
#pragma unroll
        for (int it = 0; it < 8; ++it) rs[it] = rss[row0 + (it >> 2) * HALF + (it & 3) * 16];
#pragma unroll
        for (int it = 0; it < 8; ++it) rs[it] = rsqrtf(rs[it] * (1.0f / D) + EPS);
#pragma unroll
        for (int ai = 0; ai < 2; ++ai)
#pragma unroll
            for (int m = 0; m < 4; ++m) { const int row = row0 + ai * HALF + m * 16; const float rstd = rs[ai * 4 + m]; f32x4 o[2];
#pragma unroll
                for (int n = 0; n < 2; ++n)
#pragma unroll
                    for (int j = 0; j < 4; ++j) { const float gv = rstd * acc[ai][0][m][n][j] + bg[n][j], uv = rstd * acc[ai][1][m][n][j] + bu[n][j]; o[n][j] = siluf_(gv) * uv; }
                *(u32x4*)(ACT + (size_t)row * D_FF + u.pn * HALF + cw) = pack8(o[0], o[1]); }
    }
};

struct EpiDown {
    static constexpr bool MIDK = false;
    const bf16_t* X1; const float* mod; const float* gfin; float* out; float* rss; unsigned* cnt; float amul; int fused;
    __device__ __forceinline__ void mid(Acc&, const Unit&, int, int, int, int) const {}
    __device__ __forceinline__ void operator()(Acc& acc, const Unit& u, int wr, int wc, int fr, int fq) const {
        asm volatile("" : "+v"(fr), "+v"(fq));
        const int row0 = u.pm * BM + wr * 64 + fr, col0 = u.pn * BM + wc * 32 + 8 * fq; const int b = u.pm >> 4;
        const float* mb = mod + (size_t)b * NMOD + 5 * D;
        { f32x4 gt[2][2];
#pragma unroll
          for (int bj = 0; bj < 2; ++bj)
#pragma unroll
            for (int n = 0; n < 2; ++n) gt[bj][n] = *(const f32x4*)(mb + col0 + bj * HALF + 4 * n);
          u32x4 xb[2][2];
          { const size_t o = (size_t)row0 * D + col0; xb[0][0] = *(const u32x4*)(X1 + o); xb[0][1] = *(const u32x4*)(X1 + o + HALF); }
#pragma unroll
          for (int ai = 0; ai < 2; ++ai)
#pragma unroll
            for (int m = 0; m < 4; ++m) { const int it = ai * 4 + m; const int row = row0 + ai * HALF + m * 16; float ss = 0.f;
                if (it < 7) { const size_t o2 = (size_t)(row0 + ((it + 1) >> 2) * HALF + ((it + 1) & 3) * 16) * D + col0;
                    xb[(it + 1) & 1][0] = *(const u32x4*)(X1 + o2); xb[(it + 1) & 1][1] = *(const u32x4*)(X1 + o2 + HALF); }
#pragma unroll
                for (int bj = 0; bj < 2; ++bj) { f32x4 xv[2]; unpack8(xb[it & 1][bj], xv[0], xv[1]);
#pragma unroll
                    for (int n = 0; n < 2; ++n) { const f32x4 v = xv[n] + gt[bj][n] * acc[ai][bj][m][n];
                        acc[ai][bj][m][n] = v; ss += (v[0] * v[0] + v[1] * v[1]) + (v[2] * v[2] + v[3] * v[3]); } }
                ss += __shfl_xor(ss, 16); ss += __shfl_xor(ss, 32);
                if (fq == 0) atomicAdd(rss + row, ss * amul); } }
        if (!fused) {
#pragma unroll
            for (int ai = 0; ai < 2; ++ai)
#pragma unroll
                for (int m = 0; m < 4; ++m) { const size_t o = (size_t)(row0 + ai * HALF + m * 16) * D + col0;
#pragma unroll
                    for (int bj = 0; bj < 2; ++bj)
#pragma unroll
                        for (int n = 0; n < 2; ++n) *(f32x4*)(out + o + bj * HALF + 4 * n) = acc[ai][bj][m][n]; }
            return;
        }
        asm volatile("s_waitcnt vmcnt(0)" ::: "memory");
        __builtin_amdgcn_s_barrier();
        if (threadIdx.x == 0) {
            unsigned* cw = cnt + 64 * u.pm;
            __hip_atomic_fetch_add(cw, 1u, __ATOMIC_RELAXED, __HIP_MEMORY_SCOPE_AGENT);
            unsigned sp = 0;
            while (__hip_atomic_load(cw, __ATOMIC_RELAXED, __HIP_MEMORY_SCOPE_AGENT) < 8u) { __builtin_amdgcn_s_sleep(1); if (++sp > (1u << 22)) break; }
            asm volatile("s_waitcnt vmcnt(0)" ::: "memory");
        }
        __builtin_amdgcn_s_barrier();
        asm volatile("" ::: "memory");
        f32x4 gf[2][2];
#pragma unroll
        for (int bj = 0; bj < 2; ++bj)
#pragma unroll
            for (int n = 0; n < 2; ++n) gf[bj][n] = *(const f32x4*)(gfin + col0 + bj * HALF + 4 * n);
#pragma unroll
        for (int ai = 0; ai < 2; ++ai)
#pragma unroll
            for (int m = 0; m < 4; ++m) { const int row = row0 + ai * HALF + m * 16; const size_t o = (size_t)row * D + col0;
                const float rstd = rsqrtf(__hip_atomic_load(rss + row, __ATOMIC_RELAXED, __HIP_MEMORY_SCOPE_AGENT) * (1.0f / D) + EPS);
#pragma unroll
                for (int bj = 0; bj < 2; ++bj)
#pragma unroll
                    for (int n = 0; n < 2; ++n) *(f32x4*)(out + o + bj * HALF + 4 * n) = acc[ai][bj][m][n] * rstd * gf[bj][n]; }
    }
};
}

constexpr int NWAVES = 8, NTHREADS = NWAVES * 64;
constexpr int LDS_BYTES = 147456;
constexpr int MISC_OFF = LDS_BYTES - 64;

struct Args {
    const float* in[17]; float* out; unsigned char* ws; int ph_lo, ph_hi;
};

struct Frame {
    LAS unsigned char* lds;
    int tid, lane, wave, vcu, G;
};
#define WSF(off) ((float*)(A.ws + (off)))
#define WSB(off) ((bf16_t*)(A.ws + (off)))

template <bool BIAS = false>
__device__ __forceinline__ void p0_transpose_item(const float* W, int N, bf16_t* WT, int ldk, int koff, int drow0, LAS float* scr, int k0, int n0, int lane, const LAS f32x4* shf = nullptr, float* bias = nullptr) {
    f32x4 bacc = {0.f, 0.f, 0.f, 0.f};
#pragma unroll 8
    for (int i = 0; i < 32; ++i) { const int kk = 2 * i + (lane >> 5); const float v = __builtin_nontemporal_load(W + (size_t)(k0 + kk) * N + n0 + (lane & 31)); scr[kk * 33 + (lane & 31)] = v;
        if constexpr (BIAS) bacc += shf[k0 + kk] * v; }
    if constexpr (BIAS) {
#pragma unroll
        for (int b = 0; b < 4; ++b) bacc[b] += __shfl_xor(bacc[b], 32);
        const int hb = lane >> 5; float* bp = bias + (size_t)(2 * hb) * (2 * D_FF) + drow0 + (lane & 31);
        atomicAdd(bp, hb ? bacc[2] : bacc[0]); atomicAdd(bp + 2 * D_FF, hb ? bacc[3] : bacc[1]); }
    asm volatile("s_waitcnt lgkmcnt(0)" ::: "memory");
    const int c = lane & 7;
#pragma unroll
    for (int j = 0; j < 4; ++j) { const int n = (lane >> 3) + 8 * j; const LAS float* s = scr + (8 * c) * 33 + n;
        u32x4 o; o.x = cvt_pk_bf16(s[0 * 33], s[1 * 33]); o.y = cvt_pk_bf16(s[2 * 33], s[3 * 33]); o.z = cvt_pk_bf16(s[4 * 33], s[5 * 33]); o.w = cvt_pk_bf16(s[6 * 33], s[7 * 33]);
        *(u32x4*)(WT + (size_t)(drow0 + n) * ldk + koff + k0 + 8 * c) = o; }
    asm volatile("s_waitcnt lgkmcnt(0)" ::: "memory");
}
__device__ __forceinline__ void p0_transpose_item_fp8(const float* W, int N, unsigned char* WT8, int ldk, int drow0, LAS float* scr, int k0, int n0, int lane) {
#pragma unroll 8
    for (int i = 0; i < 32; ++i) { const int kk = 2 * i + (lane >> 5); scr[kk * 33 + (lane & 31)] = __builtin_nontemporal_load(W + (size_t)(k0 + kk) * N + n0 + (lane & 31)); }
    asm volatile("s_waitcnt lgkmcnt(0)" ::: "memory");
    const int c = lane & 3;
#pragma unroll
    for (int j = 0; j < 2; ++j) { const int n = (lane >> 2) + 16 * j; const LAS float* s = scr + (16 * c) * 33 + n; u32x4 o;
        o.x = pack4_fp8(s[0 * 33] * 64.f, s[1 * 33] * 64.f, s[2 * 33] * 64.f, s[3 * 33] * 64.f); o.y = pack4_fp8(s[4 * 33] * 64.f, s[5 * 33] * 64.f, s[6 * 33] * 64.f, s[7 * 33] * 64.f);
        o.z = pack4_fp8(s[8 * 33] * 64.f, s[9 * 33] * 64.f, s[10 * 33] * 64.f, s[11 * 33] * 64.f); o.w = pack4_fp8(s[12 * 33] * 64.f, s[13 * 33] * 64.f, s[14 * 33] * 64.f, s[15 * 33] * 64.f);
        *(u32x4*)(WT8 + (size_t)(drow0 + n) * ldk + k0 + 16 * c) = o; }
    asm volatile("s_waitcnt lgkmcnt(0)" ::: "memory");
}
__device__ __forceinline__ int pair_row(int c, int second) { return 256 * (c >> 7) + 128 * second + (c & 127); }
__device__ __forceinline__ int win_dest_row(int c) {
    if (c < 1024) return 4096 + c;
    if (c < 2048) return 5120 + pair_row(c - 1024, 0);
    if (c < 3072) return 5120 + pair_row(c - 2048, 1);
    if (c < 4096) return 7168 + (c - 3072);
    if (c < 5120) return 9216 + (c - 4096);
    if (c < 6144) return 10240 + (c - 5120);
    if (c < 7168) return 8192 + (c - 6144);
    if (c < 9216) return pair_row(c - 7168, 0);
    return pair_row(c - 9216, 1);
}

__device__ __forceinline__ void phase1_rows(Frame& F, const Args& A);
__device__ __forceinline__ void phase0(Frame& F, const Args& A, float amul, bool fused) {
    const float* c_in = A.in[1]; const float* w_ada = A.in[2]; const float* b_ada = A.in[3]; const float* lb_param = A.in[7];
    float* MOD = WSF(CTL_MOD); float* LBp = WSF(CTL_LB);
    LAS float* sc = (LAS float*)(F.lds);
    LAS float* red = (LAS float*)(F.lds + 32768);
    for (int i = F.tid; i < BATCH * D; i += NTHREADS) { const float v = c_in[i]; sc[i] = v / (1.0f + __expf(-v)); }
    __syncthreads();
    for (int it = F.vcu; it < 768; it += F.G) {
        const int cb = it % 48, kc = it / 48; const int k0 = kc * 128 + F.wave * 16, col = cb * 256 + F.lane * 4;
        f32x4 a[4] = {{0.f, 0.f, 0.f, 0.f}, {0.f, 0.f, 0.f, 0.f}, {0.f, 0.f, 0.f, 0.f}, {0.f, 0.f, 0.f, 0.f}};
#pragma unroll 4
        for (int kk = 0; kk < 16; ++kk) { const f32x4 w4 = __builtin_nontemporal_load((const f32x4*)(w_ada + (size_t)(k0 + kk) * NMOD + col));
#pragma unroll
            for (int b = 0; b < 4; ++b) a[b] += w4 * sc[b * D + k0 + kk]; }
#pragma unroll
        for (int b = 0; b < 4; ++b) *(LAS f32x4*)(red + (F.wave * 4 + b) * 256 + F.lane * 4) = a[b];
        __syncthreads();
#pragma unroll
        for (int r = 0; r < 2; ++r) { const int o = F.tid + r * NTHREADS, b = o >> 8, ci = o & 255; float s = 0.f;
#pragma unroll
            for (int w = 0; w < 8; ++w) s += red[(w * 4 + b) * 256 + ci];
            if (kc == 0) s += b_ada[cb * 256 + ci];
            atomicAdd(MOD + (size_t)b * NMOD + cb * 256 + ci, s * amul); }
        __syncthreads();
    }
    if (fused) { asm volatile("s_waitcnt vmcnt(0)" ::: "memory"); __syncthreads();
        if (F.tid == 0)
            __hip_atomic_fetch_add((unsigned*)A.ws + CW_MODDONE, 1u, __ATOMIC_RELAXED, __HIP_MEMORY_SCOPE_AGENT); }
    if (F.vcu == F.G - 1) for (int i = F.tid; i < HK; i += NTHREADS) LBp[i] = 1.0f / (1.0f + __expf(lb_param[HK + i] - lb_param[i]));
    LAS float* scr = (LAS float*)(F.lds + 65536 + F.wave * 8448);
    const int gw = F.vcu * NWAVES + F.wave, NGW = F.G * NWAVES;
    constexpr int I_IN = (D / 64) * (7168 / 32), I_G8 = (D / 64) * (4096 / 32), I_G = (D / 64) * (D_FF / 32), I_D = (D_FF / 64) * (D / 32), I_C = (DC / 64) * (D / 32), I_O = (D / 64) * (D / 32);
    constexpr int NITEMS = I_IN + I_G8 + 2 * I_G + I_D + 2 * I_C + I_O;
    int it = gw;
    for (; it < I_D + I_O + 2 * I_C; it += NGW) {
        int r = it;
        if (r < I_D) { const int nb = D / 32, k0 = 64 * (r / nb), n0 = 32 * (r % nb); p0_transpose_item(A.in[15], D, WSB(WS_WT_D), D_FF, 0, n0, scr, k0, n0, F.lane); continue; } r -= I_D;
        if (r < I_O) { const int nb = D / 32, k0 = 64 * (r / nb), n0 = 32 * (r % nb); p0_transpose_item(A.in[11], D, WSB(WS_WT_O), D, 0, n0, scr, k0, n0, F.lane); continue; } r -= I_O;
        if (r < I_C) { const int nb = D / 32, k0 = 64 * (r / nb), n0 = 32 * (r % nb); p0_transpose_item(A.in[9], D, WSB(WS_WT_M), D, 0, n0, scr, k0, n0, F.lane); continue; } r -= I_C;
        { const int nb = D / 32, k0 = 64 * (r / nb), n0 = 32 * (r % nb); p0_transpose_item(A.in[10], D, WSB(WS_WT_M), D, DC, n0, scr, k0, n0, F.lane); }
    }
    const LAS f32x4* shf = (const LAS f32x4*)(F.lds);
    if (fused) { __syncthreads();
        if (F.tid == 0) { unsigned* cw = (unsigned*)A.ws + CW_MODDONE; unsigned sp = 0;
            while (__hip_atomic_load(cw, __ATOMIC_RELAXED, __HIP_MEMORY_SCOPE_AGENT) < (unsigned)F.G) { __builtin_amdgcn_s_sleep(2); if (++sp > (1u << 22)) break; }
            __builtin_amdgcn_fence(__ATOMIC_ACQUIRE, "agent"); asm volatile("s_waitcnt vmcnt(0)" ::: "memory"); }
        __syncthreads();
        for (int i = F.tid; i < D; i += NTHREADS) { f32x4 v; v[0] = MOD[0 * (size_t)NMOD + 3 * D + i]; v[1] = MOD[1 * (size_t)NMOD + 3 * D + i]; v[2] = MOD[2 * (size_t)NMOD + 3 * D + i]; v[3] = MOD[3 * (size_t)NMOD + 3 * D + i];
            ((LAS f32x4*)(F.lds))[i] = v; }
        __syncthreads(); }
    for (; it < NITEMS; it += NGW) {
        int r = it;
        if (fused) { int q = r - (I_D + I_O + 2 * I_C);
            if (q < I_G) { const int nb = D_FF / 32, k0 = 64 * (q / nb), n0 = 32 * (q % nb); p0_transpose_item<true>(A.in[13], D_FF, WSB(WS_WT_GU), D, 0, pair_row(n0, 0), scr, k0, n0, F.lane, shf, WSF(CTL_BIASGU)); continue; } q -= I_G;
            if (q < I_G) { const int nb = D_FF / 32, k0 = 64 * (q / nb), n0 = 32 * (q % nb); p0_transpose_item<true>(A.in[14], D_FF, WSB(WS_WT_GU), D, 0, pair_row(n0, 1), scr, k0, n0, F.lane, shf, WSF(CTL_BIASGU)); continue; } }
        if (r < I_D) { const int nb = D / 32, k0 = 64 * (r / nb), n0 = 32 * (r % nb); p0_transpose_item(A.in[15], D, WSB(WS_WT_D), D_FF, 0, n0, scr, k0, n0, F.lane); continue; } r -= I_D;
        if (r < I_O) { const int nb = D / 32, k0 = 64 * (r / nb), n0 = 32 * (r % nb); p0_transpose_item(A.in[11], D, WSB(WS_WT_O), D, 0, n0, scr, k0, n0, F.lane); continue; } r -= I_O;
        if (r < I_C) { const int nb = D / 32, k0 = 64 * (r / nb), n0 = 32 * (r % nb); p0_transpose_item(A.in[9], D, WSB(WS_WT_M), D, 0, n0, scr, k0, n0, F.lane); continue; } r -= I_C;
        if (r < I_C) { const int nb = D / 32, k0 = 64 * (r / nb), n0 = 32 * (r % nb); p0_transpose_item(A.in[10], D, WSB(WS_WT_M), D, DC, n0, scr, k0, n0, F.lane); continue; } r -= I_C;
        if (r < I_G) { const int nb = D_FF / 32, k0 = 64 * (r / nb), n0 = 32 * (r % nb); p0_transpose_item(A.in[13], D_FF, WSB(WS_WT_GU), D, 0, pair_row(n0, 0), scr, k0, n0, F.lane); continue; } r -= I_G;
        if (r < I_G) { const int nb = D_FF / 32, k0 = 64 * (r / nb), n0 = 32 * (r % nb); p0_transpose_item(A.in[14], D_FF, WSB(WS_WT_GU), D, 0, pair_row(n0, 1), scr, k0, n0, F.lane); continue; } r -= I_G;
        if (r < I_G8) { const int nb = 4096 / 32, k0 = 64 * (r / nb), n0 = 7168 + 32 * (r % nb); p0_transpose_item_fp8(A.in[5], D_IN, A.ws + WS_WT8, D, win_dest_row(n0), scr, k0, n0, F.lane); continue; } r -= I_G8;
        { const int nb = 7168 / 32, k0 = 64 * (r / nb), n0 = 32 * (r % nb); p0_transpose_item(A.in[5], D_IN, WSB(WS_WT_IN), D, 0, win_dest_row(n0), scr, k0, n0, F.lane); }
    }
    if (fused) { __syncthreads(); phase1_rows(F, A); }
}

__device__ __forceinline__ void phase1_rows(Frame& F, const Args& A) {
    const float* x = A.in[0]; const float* g_mix = A.in[4]; const float* MOD = WSF(CTL_MOD); bf16_t* H = WSB(WS_H); unsigned char* H8 = A.ws + WS_H8;
    LAS float* PA = (LAS float*)(F.lds);
    LAS float* PB = (LAS float*)(F.lds + 32768);
    for (int i = F.tid; i < BATCH * D; i += NTHREADS) { const int b = i >> 11, col = i & (D - 1); const float* mb = MOD + (size_t)b * NMOD;
        PA[i] = g_mix[col] * (1.0f + mb[D + col]); PB[i] = mb[col]; }
    __syncthreads();
    const int gw = F.vcu * NWAVES + F.wave, NGW = F.G * NWAVES;
    for (int m = gw; m < M; m += NGW) {
        const int b = m >> 12; const f32x4* xr = (const f32x4*)(x + (size_t)m * D) + F.lane;
        f32x4 v[8]; float s = 0.f;
#pragma unroll
        for (int j = 0; j < 8; ++j) { v[j] = __builtin_nontemporal_load(xr + 64 * j); s += (v[j][0] * v[j][0] + v[j][1] * v[j][1]) + (v[j][2] * v[j][2] + v[j][3] * v[j][3]); }
        const float rstd = rsqrtf(wave_sum(s) * (1.0f / D) + EPS);
        u32x2* o8 = (u32x2*)(H + (size_t)m * D) + F.lane; unsigned* o4 = (unsigned*)(H8 + (size_t)m * D) + F.lane;
#pragma unroll
        for (int j = 0; j < 8; ++j) { const f32x4 a = *(const LAS f32x4*)(PA + b * D + 256 * j + 4 * F.lane), sh = *(const LAS f32x4*)(PB + b * D + 256 * j + 4 * F.lane);
            const f32x4 h = v[j] * rstd * a + sh; u32x2 w; w.x = cvt_pk_bf16(h[0], h[1]); w.y = cvt_pk_bf16(h[2], h[3]); o8[64 * j] = w; o4[64 * j] = pack4_fp8(h[0], h[1], h[2], h[3]); }
    }
}
__device__ __forceinline__ void phase_biasgu(Frame& F, const Args& A) {
    const float* MOD = WSF(CTL_MOD); float* BIASGU = WSF(CTL_BIASGU); const bf16_t* WT_GU = WSB(WS_WT_GU);
    LAS float* PS = (LAS float*)(F.lds + 65536);
    for (int i = F.tid; i < BATCH * D; i += NTHREADS) { const int b = i >> 11, col = i & (D - 1); PS[i] = MOD[(size_t)b * NMOD + 3 * D + col]; }
    __syncthreads();
    const int gw = F.vcu * NWAVES + F.wave, NGW = F.G * NWAVES;
    for (int n = gw; n < 2 * D_FF; n += NGW) {
        const u32x4* wr_ = (const u32x4*)(WT_GU + (size_t)n * D) + F.lane;
        float a[4] = {0.f, 0.f, 0.f, 0.f};
#pragma unroll
        for (int j = 0; j < 4; ++j) { const u32x4 w = wr_[64 * j]; f32x4 w0, w1; pg8::unpack8(w, w0, w1); const int k = 512 * j + 8 * F.lane;
#pragma unroll
            for (int b = 0; b < 4; ++b) { const f32x4 s0 = *(const LAS f32x4*)(PS + b * D + k), s1 = *(const LAS f32x4*)(PS + b * D + k + 4);
                a[b] += (w0[0] * s0[0] + w0[1] * s0[1]) + (w0[2] * s0[2] + w0[3] * s0[3]) + (w1[0] * s1[0] + w1[1] * s1[1]) + (w1[2] * s1[2] + w1[3] * s1[3]); } }
#pragma unroll
        for (int b = 0; b < 4; ++b) { const float t = wave_sum(a[b]); if (F.lane == 0) BIASGU[(size_t)b * (2 * D_FF) + n] = t; }
    }
    __syncthreads();
}
__device__ __forceinline__ void phase1(Frame& F, const Args& A) { phase1_rows(F, A); __syncthreads(); phase_biasgu(F, A); }

constexpr int RS = 272, RS_V = 272;
constexpr int SC_RAWSZ = 21632, SC_RAWL = 17408, SC_AIMG = 3 * SC_RAWSZ, SC_DEC = SC_AIMG + 2 * 2304;
struct ScanRegs { u32x4 v0, v1; f32x4 lf; };
__device__ __forceinline__ void scan_load(ScanRegs& R, const bf16_t* vg, const float* lg, int chunk, int tid) {
    const size_t r0 = (size_t)chunk * CHUNK;
    R.v0 = *(const u32x4*)(vg + (r0 + (tid >> 4)) * HV + (tid & 15) * 8);
    R.v1 = *(const u32x4*)(vg + (r0 + 32 + (tid >> 4)) * HV + (tid & 15) * 8);
    if (tid < 256) R.lf = *(const f32x4*)(lg + (r0 + (tid >> 2)) * HK + (tid & 3) * 4);
}
__device__ __forceinline__ void scan_write(const ScanRegs& R, LAS unsigned char* L, int slot, int tid) {
    LAS unsigned char* base = L + slot * SC_RAWSZ;
    *(LAS u32x4*)(base + (tid >> 4) * RS_V + (tid & 15) * 16) = R.v0;
    *(LAS u32x4*)(base + (32 + (tid >> 4)) * RS_V + (tid & 15) * 16) = R.v1;
    if (tid < 256) { const int t = tid >> 2, cq = tid & 3;
#pragma unroll
        for (int i = 0; i < 4; ++i) *(LAS float*)(base + SC_RAWL + (4 * cq + i) * 264 + 4 * t) = R.lf[i]; }
}
#define DPP_SHR(x, n) __int_as_float(__builtin_amdgcn_update_dpp(0, __float_as_int(x), 0x110 | (n), 0xf, 0xf, true))
__device__ __forceinline__ f32x2 scan_aread(LAS unsigned char* L, int slot, int w, int lane) {
    return *(const LAS f32x2*)(L + slot * SC_RAWSZ + SC_RAWL + (2 * w + (lane >> 5)) * 264 + 8 * (lane & 31));
}
__device__ __forceinline__ void scan_apart(LAS unsigned char* L, const f32x2 lf, int p, int w, int lane) {
    const int c = 2 * w + (lane >> 5), tt = lane & 31; const bool hi = (lane & 32) != 0;
    float x = lf.x + lf.y;
    x += DPP_SHR(x, 1); x += DPP_SHR(x, 2); x += DPP_SHR(x, 4); x += DPP_SHR(x, 8);
    const float r0 = __int_as_float(__builtin_amdgcn_readlane(__float_as_int(x), 15)), r1 = __int_as_float(__builtin_amdgcn_readlane(__float_as_int(x), 47));
    if (lane & 16) x += hi ? r1 : r0;
    const float b0 = __int_as_float(__builtin_amdgcn_readlane(__float_as_int(x), 31)), b1 = __int_as_float(__builtin_amdgcn_readlane(__float_as_int(x), 63));
    const float blast = hi ? b1 : b0;
    const float bc1 = x, bc0 = x - lf.y;
    const float k0 = (1.0f - fast_exp(lf.x)) * fast_exp(blast - bc0), k1 = (1.0f - fast_exp(lf.y)) * fast_exp(blast - bc1);
    *(LAS unsigned*)(L + SC_AIMG + p * 2304 + c * 144 + 4 * tt) = cvt_pk_bf16(k0, k1);
    if (tt == 31) *(LAS float*)(L + SC_DEC + p * 64 + 4 * c) = fast_exp(blast);
}
__device__ __forceinline__ void scan_item(Frame& F, const float* LOGF, const bf16_t* V, bf16_t* SST, int item) {
    const int b = item >> 6, h = (item >> 3) & 7, ks = item & 7;
    const int tid = F.tid, lane = F.lane, w = F.wave, l15 = lane & 15, g = lane >> 4;
    LAS unsigned char* L = F.lds;
    const float* lg = LOGF + (size_t)(b * SEQ) * HK + h * 128 + ks * 16;
    const bf16_t* vg = V + (size_t)(b * SEQ) * HV + h * 128;
    bf16_t* sp = SST + ((size_t)((b * NH + h) * NCHUNK) * 128 + 16 * w + l15) * 128 + ks * 16 + 4 * g;
    ScanRegs R0, R1, R2, R3, R4, R5;
    R0.lf = (f32x4){0.f, 0.f, 0.f, 0.f}; R1.lf = R0.lf; R2.lf = R0.lf; R3.lf = R0.lf; R4.lf = R0.lf; R5.lf = R0.lf;
    scan_load(R4, vg, lg, 0, tid); scan_load(R5, vg, lg, 1, tid);
    scan_load(R0, vg, lg, 2, tid); scan_load(R1, vg, lg, 3, tid); scan_load(R2, vg, lg, 4, tid); scan_load(R3, vg, lg, 5, tid);
    scan_write(R4, L, 0, tid); scan_write(R5, L, 1, tid);
    scan_load(R4, vg, lg, 6, tid);
    __syncthreads();
    scan_apart(L, scan_aread(L, 0, w, lane), 0, w, lane);
    __syncthreads();
    f32x4 S = {0.f, 0.f, 0.f, 0.f};
    int n = 0, s0 = 0, s1 = 1, s2 = 2;
    const unsigned voff = (unsigned)((8 * g + (l15 >> 2)) * RS_V + 32 * w + 8 * (lane & 3));
#define SCAN_STEP(Ra, Rc) do { \
        scan_load(Rc, vg, lg, (n + 7 < NCHUNK ? n + 7 : NCHUNK - 1), tid); \
        { u32x2 wv; wv.x = cvt_pk_bf16(S[0], S[1]); wv.y = cvt_pk_bf16(S[2], S[3]); *(u32x2*)(sp + (size_t)n * 128 * 128) = wv; } \
        const f32x2 lfn = scan_aread(L, s1, w, lane); \
        { const int p = n & 1; const LAS unsigned char* ai = L + SC_AIMG + p * 2304 + l15 * 144 + 16 * g; \
          const bf16x8 A0 = *(const LAS bf16x8*)ai, A1 = *(const LAS bf16x8*)(ai + 64); \
          const f32x4 dec = *(const LAS f32x4*)(L + SC_DEC + p * 64 + 16 * g); \
          const unsigned vb = (unsigned)(uintptr_t)(L + s0 * SC_RAWSZ) + voff; \
          u32x2 t00, t01, t10, t11; \
          asm volatile("ds_read_b64_tr_b16 %0, %4\n\tds_read_b64_tr_b16 %1, %4 offset:1088\n\tds_read_b64_tr_b16 %2, %4 offset:8704\n\tds_read_b64_tr_b16 %3, %4 offset:9792\n\ts_waitcnt lgkmcnt(0)" \
                       : "=&v"(t00), "=&v"(t01), "=&v"(t10), "=&v"(t11) : "v"(vb) : "memory"); \
          const u32x4 q0 = {t00.x, t00.y, t01.x, t01.y}, q1 = {t10.x, t10.y, t11.x, t11.y}; \
          f32x4 Cin = S * dec; \
          Cin = __builtin_amdgcn_mfma_f32_16x16x32_bf16(A0, __builtin_bit_cast(bf16x8, q0), Cin, 0, 0, 0); \
          S = __builtin_amdgcn_mfma_f32_16x16x32_bf16(A1, __builtin_bit_cast(bf16x8, q1), Cin, 0, 0, 0); } \
        scan_apart(L, lfn, (n + 1) & 1, w, lane); \
        scan_write(Ra, L, s2, tid); \
        __syncthreads(); \
        { const int t_ = s0; s0 = s1; s1 = s2; s2 = t_; ++n; } } while (0)
    for (int it = 0; it < 10; ++it) { SCAN_STEP(R0, R5); SCAN_STEP(R1, R0); SCAN_STEP(R2, R1); SCAN_STEP(R3, R2); SCAN_STEP(R4, R3); SCAN_STEP(R5, R4); }
    SCAN_STEP(R0, R5); SCAN_STEP(R1, R0); SCAN_STEP(R2, R1);
#undef SCAN_STEP
    { u32x2 wv; wv.x = cvt_pk_bf16(S[0], S[1]); wv.y = cvt_pk_bf16(S[2], S[3]); *(u32x2*)(sp + (size_t)n * 128 * 128) = wv; }
    __syncthreads();
}
__device__ __forceinline__ void phase3a(Frame& F, const Args& A) {
    for (int it = F.vcu; it < BATCH * NH * 8; it += F.G) scan_item(F, WSF(WS_LOGF), WSB(WS_V), WSB(WS_H), it);
}

constexpr int L_QT = 0, L_KB = 17408, L_VS = 34816, L_QA = 52224, L_SC = 95744, L_TOT = 104960, L_RR = 107008, L_SSQ = 109056, SCS = 144;
struct OutPtrs { const float* LOGF; const bf16_t *Q, *V, *GO, *SST; const float* gnorm; bf16_t* ZO; const bf16_t *U, *AB; const float* conv_w; };
struct OutRegs { f32x2 lf[8]; unsigned qq[8]; u32x4 vv[2]; bf16x8 SA[4]; u32x4 cu0[2], cu1[2], cu2[2], cab[2]; u32x2 go[4]; };
__device__ __forceinline__ void out_ld1(OutRegs& R, const OutPtrs& P, int item, int tid, int lane, int w) {
    const int b = item >> 9, h = (item >> 6) & 7, n = item & 63; const size_t row0 = (size_t)b * SEQ + (size_t)n * CHUNK;
    const float* lfp = P.LOGF + (row0 + 8 * w) * HK + h * 128 + 2 * lane; const bf16_t* qp = P.Q + (row0 + 8 * w) * HK + h * 128 + 2 * lane;
#pragma unroll
    for (int i = 0; i < 8; ++i) { R.lf[i] = *(const f32x2*)(lfp + (size_t)i * HK); R.qq[i] = *(const unsigned*)(qp + (size_t)i * HK); }
#pragma unroll
    for (int j = 0; j < 2; ++j) { const int id = tid + 512 * j, r = id >> 4, ch = id & 15; R.vv[j] = *(const u32x4*)(P.V + (row0 + r) * HV + h * 128 + ch * 8); }
}
__device__ __forceinline__ void out_ldS(OutRegs& R, const OutPtrs& P, int item, int lane, int w) {
    const bf16_t* sp = P.SST + ((size_t)item * 128 + 16 * w + (lane & 15)) * 128 + 8 * (lane >> 4);
#pragma unroll
    for (int ks = 0; ks < 4; ++ks) R.SA[ks] = *(const bf16x8*)(sp + 32 * ks);
}
__device__ __forceinline__ void out_ldC(OutRegs& R, const OutPtrs& P, int item, int tid) {
    const int b = item >> 9, h = (item >> 6) & 7, n = item & 63; const size_t row0 = (size_t)b * SEQ + (size_t)n * CHUNK; const u32x4 z4 = {0u, 0u, 0u, 0u};
#pragma unroll
    for (int j = 0; j < 2; ++j) { const int r = (tid >> 4) + 32 * j, t = n * CHUNK + r; const size_t o = (row0 + r) * DC + h * 128 + (tid & 15) * 8;
        R.cu2[j] = *(const u32x4*)(P.U + o); R.cu1[j] = t >= 1 ? *(const u32x4*)(P.U + o - DC) : z4; R.cu0[j] = t >= 2 ? *(const u32x4*)(P.U + o - 2 * DC) : z4; R.cab[j] = *(const u32x4*)(P.AB + o); }
}
__device__ __forceinline__ void out_ldG(OutRegs& R, const OutPtrs& P, int item, int lane, int w) {
    const int b = item >> 9, h = (item >> 6) & 7, n = item & 63; const size_t row0 = (size_t)b * SEQ + (size_t)n * CHUNK;
#pragma unroll
    for (int tb = 0; tb < 4; ++tb) R.go[tb] = *(const u32x2*)(P.GO + (row0 + 16 * tb + (lane & 15)) * HV + h * 128 + 16 * w + 4 * (lane >> 4));
}
__device__ __forceinline__ void out_items(Frame& F, const OutPtrs& P, int first, int count, int stride) {
    const int tid = F.tid, lane = F.lane, w = F.wave, l15 = lane & 15, g = lane >> 4;
    LAS unsigned char* L = F.lds;
    if (count <= 0) return;
    OutRegs R;
    out_ld1(R, P, first, tid, lane, w); out_ldC(R, P, first, tid); out_ldS(R, P, first, lane, w); out_ldG(R, P, first, lane, w);
    for (int q = 0; q < count; ++q) {
    const int item = first + q * stride, nitem = item + stride; const bool more = (q + 1 < count);
    const int b = item >> 9, h = (item >> 6) & 7, n = item & 63;
    const size_t row0 = (size_t)b * SEQ + (size_t)n * CHUNK;
    {
#pragma unroll
      for (int j = 0; j < 2; ++j) { const int id = tid + 512 * j, r = id >> 4, ch = id & 15; *(LAS u32x4*)(L + L_VS + r * RS + ch * 16) = R.vv[j]; }
      f32x2 bc[8]; f32x2 run = {0.f, 0.f};
#pragma unroll
      for (int i = 0; i < 8; ++i) { run += R.lf[i]; bc[i] = run; }
      *(LAS f32x2*)(L + L_TOT + (w * 128 + 2 * lane) * 4) = run;
      __syncthreads();
      f32x2 off = {0.f, 0.f}, rown = {0.f, 0.f}, rj[3] = {{0.f, 0.f}, {0.f, 0.f}, {0.f, 0.f}}; const int tb = w >> 1;
      { f32x2 pacc = {0.f, 0.f};
#pragma unroll
        for (int j = 0; j < 8; ++j) { pacc += *(const LAS f32x2*)(L + L_TOT + (j * 128 + 2 * lane) * 4);
            if (j < w) off = pacc;
            if ((j & 1) == 0) { if (j == 2 * tb) rown = pacc; if ((j >> 1) < 3 && (j >> 1) < tb) rj[j >> 1] = pacc; } } }
      const f32x2 er = {fast_exp(rown.x), fast_exp(rown.y)};
      f32x2 ej[3];
#pragma unroll
      for (int j = 0; j < 3; ++j) { ej[j].x = fast_exp(rown.x - rj[j].x); ej[j].y = fast_exp(rown.y - rj[j].y); }
      const int pd = tb * (tb + 1) / 2 + tb, rb = 8 * (w & 1);
#pragma unroll
      for (int i = 0; i < 8; ++i) { const int t = 8 * w + i;
          const f32x2 bb = bc[i] + off; const f32x2 qv = {__uint_as_float(R.qq[i] << 16), __uint_as_float(R.qq[i] & 0xffff0000u)};
          const f32x2 E = {fast_exp(bb.x - rown.x), fast_exp(bb.y - rown.y)}; const f32x2 Ei = {fast_rcp(E.x), fast_rcp(E.y)};
          const f32x2 kk = {1.0f - fast_exp(R.lf[i].x), 1.0f - fast_exp(R.lf[i].y)};
          const f32x2 qe = qv * E;
          *(LAS unsigned*)(L + L_QT + t * RS + 4 * lane) = cvt_pk_bf16(qe.x * er.x, qe.y * er.y);
          *(LAS unsigned*)(L + L_KB + t * RS + 4 * lane) = cvt_pk_bf16(kk.x * Ei.x, kk.y * Ei.y);
          *(LAS unsigned*)(L + L_QA + (pd * 16 + rb + i) * RS + 4 * lane) = cvt_pk_bf16(qe.x, qe.y);
#pragma unroll
          for (int j = 0; j < 3; ++j) if (j < tb) *(LAS unsigned*)(L + L_QA + ((tb * (tb + 1) / 2 + j) * 16 + rb + i) * RS + 4 * lane) = cvt_pk_bf16(qe.x * ej[j].x, qe.y * ej[j].y); }
      if (more) out_ld1(R, P, nitem, tid, lane, w);
      { const int c8 = h * 128 + (tid & 15) * 8; f32x4 w0[2], w1[2], w2[2];
#pragma unroll
        for (int qq2 = 0; qq2 < 2; ++qq2) { w0[qq2] = *(const f32x4*)(P.conv_w + c8 + 4 * qq2); w1[qq2] = *(const f32x4*)(P.conv_w + DC + c8 + 4 * qq2); w2[qq2] = *(const f32x4*)(P.conv_w + 2 * DC + c8 + 4 * qq2); }
#pragma unroll
        for (int j = 0; j < 2; ++j) { const int r = (tid >> 4) + 32 * j;
            f32x4 a0, a1, b0, b1, c0, c1, d0, d1; pg8::unpack8(R.cu0[j], a0, a1); pg8::unpack8(R.cu1[j], b0, b1); pg8::unpack8(R.cu2[j], c0, c1); pg8::unpack8(R.cab[j], d0, d1);
            const f32x4 z0 = d0 * (w0[0] * a0 + w1[0] * b0 + w2[0] * c0), z1 = d1 * (w0[1] * a1 + w1[1] * b1 + w2[1] * c1);
            *(u32x4*)(P.ZO + (row0 + r) * D + c8) = pg8::pack8(z0, z1); } }
      if (more) out_ldC(R, P, nitem, tid);
      __syncthreads(); }
    for (int p = w; p < 10; p += 8) {
        const int i = p < 1 ? 0 : (p < 3 ? 1 : (p < 6 ? 2 : 3)), j = p - i * (i + 1) / 2;
        f32x4 a = {0.f, 0.f, 0.f, 0.f};
#pragma unroll
        for (int ks = 0; ks < 4; ++ks) { const bf16x8 ka = *(const LAS bf16x8*)(L + L_KB + (16 * j + l15) * RS + 64 * ks + 16 * g), qb = *(const LAS bf16x8*)(L + L_QA + (p * 16 + l15) * RS + 64 * ks + 16 * g);
            a = __builtin_amdgcn_mfma_f32_16x16x32_bf16(ka, qb, a, 0, 0, 0); }
        if (i == j) {
#pragma unroll
            for (int r = 0; r < 4; ++r) if (4 * g + r > l15) a[r] = 0.f; }
        u32x2 wv; wv.x = cvt_pk_bf16(a[0], a[1]); wv.y = cvt_pk_bf16(a[2], a[3]);
        *(LAS u32x2*)(L + L_SC + (16 * i + l15) * SCS + (16 * j + 4 * g) * 2) = wv;
    }
    if (w == 2 || w == 3) { const int i = (w == 2) ? 0 : 2, j = i + 1; const u32x2 z = {0u, 0u}; *(LAS u32x2*)(L + L_SC + (16 * i + l15) * SCS + (16 * j + 4 * g) * 2) = z; }
    __syncthreads();
    f32x4 o[4];
#pragma unroll
    for (int tb = 0; tb < 4; ++tb) { o[tb] = (f32x4){0.f, 0.f, 0.f, 0.f};
#pragma unroll
        for (int ks = 0; ks < 4; ++ks) { const bf16x8 qb = *(const LAS bf16x8*)(L + L_QT + (16 * tb + l15) * RS + 64 * ks + 16 * g);
            o[tb] = __builtin_amdgcn_mfma_f32_16x16x32_bf16(R.SA[ks], qb, o[tb], 0, 0, 0); } }
    if (more) out_ldS(R, P, nitem, lane, w);
    {
      const unsigned vb = (unsigned)(uintptr_t)(L + L_VS) + (unsigned)((8 * g + (l15 >> 2)) * RS + 32 * w + 8 * (lane & 3));
      u32x2 t00, t01, t10, t11;
      asm volatile("ds_read_b64_tr_b16 %0, %4\n\tds_read_b64_tr_b16 %1, %4 offset:1088\n\tds_read_b64_tr_b16 %2, %4 offset:8704\n\tds_read_b64_tr_b16 %3, %4 offset:9792\n\ts_waitcnt lgkmcnt(0)"
                   : "=&v"(t00), "=&v"(t01), "=&v"(t10), "=&v"(t11) : "v"(vb) : "memory");
      bf16x8 VA0, VA1;
      { u32x4 q0 = {t00.x, t00.y, t01.x, t01.y}, q1 = {t10.x, t10.y, t11.x, t11.y}; VA0 = __builtin_bit_cast(bf16x8, q0); VA1 = __builtin_bit_cast(bf16x8, q1); }
#pragma unroll
      for (int tb = 0; tb < 4; ++tb) { const bf16x8 s0 = *(const LAS bf16x8*)(L + L_SC + (16 * tb + l15) * SCS + 16 * g);
          o[tb] = __builtin_amdgcn_mfma_f32_16x16x32_bf16(VA0, s0, o[tb], 0, 0, 0);
          if (tb >= 2) { const bf16x8 s1 = *(const LAS bf16x8*)(L + L_SC + (16 * tb + l15) * SCS + 64 + 16 * g); o[tb] = __builtin_amdgcn_mfma_f32_16x16x32_bf16(VA1, s1, o[tb], 0, 0, 0); } } }
#pragma unroll
    for (int tb = 0; tb < 4; ++tb) { float s = (o[tb][0] * o[tb][0] + o[tb][1] * o[tb][1]) + (o[tb][2] * o[tb][2] + o[tb][3] * o[tb][3]);
        s += __shfl_xor(s, 16); s += __shfl_xor(s, 32);
        if (g == 0) ((LAS float*)(L + L_SSQ))[(16 * tb + l15) * 8 + w] = s; }
    __syncthreads();
    const f32x4 gn = *(const f32x4*)(P.gnorm + 16 * w + 4 * g);
#pragma unroll
    for (int tb = 0; tb < 4; ++tb) { const int t = 16 * tb + l15;
        const f32x4 s0 = *(const LAS f32x4*)(L + L_SSQ + t * 32), s1 = *(const LAS f32x4*)(L + L_SSQ + t * 32 + 16);
        const float rstd = rsqrtf(((s0[0] + s0[1]) + (s0[2] + s0[3]) + (s1[0] + s1[1]) + (s1[2] + s1[3])) * (1.0f / 128.0f) + EPS);
        const u32x2 gv = R.go[tb];
        const float g0 = __uint_as_float(gv.x << 16), g1 = __uint_as_float(gv.x & 0xffff0000u), g2 = __uint_as_float(gv.y << 16), g3 = __uint_as_float(gv.y & 0xffff0000u);
        u32x2 wv; wv.x = cvt_pk_bf16(o[tb][0] * rstd * gn[0] * g0, o[tb][1] * rstd * gn[1] * g1); wv.y = cvt_pk_bf16(o[tb][2] * rstd * gn[2] * g2, o[tb][3] * rstd * gn[3] * g3);
        *(u32x2*)(P.ZO + (row0 + t) * D + DC + h * 128 + 16 * w + 4 * g) = wv; }
    if (more) out_ldG(R, P, nitem, lane, w);
    __syncthreads();
    }
}
__device__ __forceinline__ void phase3b(Frame& F, const Args& A) {
    const OutPtrs P{WSF(WS_LOGF), WSB(WS_Q), WSB(WS_V), WSB(WS_G), WSB(WS_H), A.in[8], WSB(WS_ZO), WSB(WS_U), WSB(WS_AB), A.in[6]};
    const int total = BATCH * NH * NCHUNK;
    out_items(F, P, F.vcu, F.vcu < total ? (total - F.vcu + F.G - 1) / F.G : 0, F.G);
}
__device__ __forceinline__ void phase3ab_fused(Frame& F, const Args& A, unsigned myx1) {
    const int item = F.vcu;
    unsigned pv = myx1;
    if (F.wave == 0 && F.lane < 8) pv = __hip_atomic_load((unsigned*)A.ws + CW_XCCTAB + (item & ~7) + F.lane, __ATOMIC_RELAXED, __HIP_MEMORY_SCOPE_AGENT);
    scan_item(F, WSF(WS_LOGF), WSB(WS_V), WSB(WS_H), item);
    asm volatile("s_waitcnt vmcnt(0)" ::: "memory");
    __syncthreads();
    const bool same_xcd = (__ballot(pv != myx1) == 0ull);
    if (F.tid == 0) { unsigned* cw = (unsigned*)A.ws + CW_HEAD + 64 * (item >> 3);
        if (!same_xcd) { __builtin_amdgcn_fence(__ATOMIC_RELEASE, "agent"); asm volatile("s_waitcnt vmcnt(0)" ::: "memory"); }
        __hip_atomic_fetch_add(cw, 1u, __ATOMIC_RELAXED, __HIP_MEMORY_SCOPE_AGENT);
        unsigned sp = 0;
        while (__hip_atomic_load(cw, __ATOMIC_RELAXED, __HIP_MEMORY_SCOPE_AGENT) < 8u) { __builtin_amdgcn_s_sleep(2); if (++sp > (1u << 22)) break; }
        __builtin_amdgcn_fence(__ATOMIC_ACQUIRE, "agent"); asm volatile("s_waitcnt vmcnt(0)" ::: "memory"); }
    __syncthreads();
    const OutPtrs P{WSF(WS_LOGF), WSB(WS_Q), WSB(WS_V), WSB(WS_G), WSB(WS_H), A.in[8], WSB(WS_ZO), WSB(WS_U), WSB(WS_AB), A.in[6]};
    const int bh = item >> 3, ks = item & 7;
#ifdef PROBE_P3X
    for (int rep = 0; rep <= PROBE_P3X; ++rep) { __syncthreads(); out_items(F, P, bh * NCHUNK + ks * 8, 8, 1); }
#else
    out_items(F, P, bh * NCHUNK + ks * 8, 8, 1);
#endif
}

__device__ __forceinline__ void phase8(Frame& F, const Args& A) {
    const float* g_final = A.in[16]; const float* RSS2 = WSF(CTL_RSS2); float* out = A.out;
    const int gw = F.vcu * NWAVES + F.wave, NGW = F.G * NWAVES;
    f32x4 gf[8];
#pragma unroll
    for (int j = 0; j < 8; ++j) gf[j] = *((const f32x4*)g_final + F.lane + 64 * j);
    for (int m = gw; m < M; m += NGW) {
        const float rstd = rsqrtf(RSS2[m] * (1.0f / D) + EPS);
        f32x4* xr = (f32x4*)(out + (size_t)m * D) + F.lane;
#pragma unroll
        for (int j = 0; j < 8; ++j) xr[64 * j] = xr[64 * j] * rstd * gf[j];
    }
}

#define XB_TMO      128
#define XB_XCNT(j)  (256  + 64 * (j))
#define XB_XSUB(j)  (1280 + 64 * (j))
#define XB_XGEN(j)  (2304 + 64 * (j))
#define XB_TOP      3328
#define XB_TOPGEN   3392
#define XCD_BAR_WORDS 3456
#define XB_SPIN_CAP (1u << 18)
__device__ __forceinline__ unsigned xb_ld(unsigned* p)              { return __hip_atomic_load(p, __ATOMIC_RELAXED, __HIP_MEMORY_SCOPE_AGENT); }
__device__ __forceinline__ unsigned xb_add(unsigned* p, unsigned v) { return __hip_atomic_fetch_add(p, v, __ATOMIC_RELAXED, __HIP_MEMORY_SCOPE_AGENT); }
__device__ __forceinline__ unsigned xb_xcc_id() { return (unsigned)__builtin_amdgcn_s_getreg((3 << 11) | 20) & 0xFu; }
#define XB_SPIN(cond, bar) do { unsigned _sp = 0; while (cond) { __builtin_amdgcn_s_sleep(1); \
    if ((++_sp & 255u) == 0u) { if (xb_ld(&(bar)[XB_TMO])) break; if (_sp > XB_SPIN_CAP) { atomicAdd(&(bar)[XB_TMO], 1u); break; } } } } while (0)
struct XcdBarrier { unsigned* bar; unsigned x; volatile LAS unsigned* st; };
__device__ __forceinline__ XcdBarrier xcd_barrier_post(unsigned* bar, volatile LAS unsigned* st) {
    XcdBarrier b; b.bar = bar; b.x = xb_xcc_id(); b.st = st;
    if (threadIdx.x == 0) (void)xb_add(&bar[XB_XCNT(b.x)], 1u);
    return b;
}
__device__ __forceinline__ void xcd_barrier_complete(unsigned* bar, unsigned x, unsigned& nloc, unsigned& nx) {
    const unsigned G = gridDim.x * gridDim.y * gridDim.z;
    unsigned sum, cnt, mine, sp = 0u;
    for (;;) {
        sum = 0u; cnt = 0u; mine = 0u;
#pragma unroll
        for (unsigned j = 0; j < 16; ++j) { const unsigned c = xb_ld(&bar[XB_XCNT(j)]); sum += c; cnt += (c > 0u) ? 1u : 0u; mine = (j == x) ? c : mine; }
        if (sum == G) break;
        __builtin_amdgcn_s_sleep(1);
        if ((++sp & 255u) == 0u) { if (xb_ld(&bar[XB_TMO])) break; if (sp > XB_SPIN_CAP) { atomicAdd(&bar[XB_TMO], 1u); break; } }
    }
    nloc = mine > 0u ? mine : 1u; nx = cnt > 0u ? cnt : 1u;
}
__device__ __forceinline__ void xcd_barrier(const XcdBarrier& b) {
    asm volatile("s_waitcnt vmcnt(0)" ::: "memory");
    __syncthreads();
    if (threadIdx.x == 0) {
        unsigned* bar = b.bar;
        __builtin_amdgcn_s_waitcnt(0);
        unsigned nloc = b.st[0], nx = b.st[1];
        if (nloc == 0u) { xcd_barrier_complete(bar, b.x, nloc, nx); b.st[0] = nloc; b.st[1] = nx; }
        const unsigned old = xb_add(&bar[XB_XSUB(b.x)], 1u);
        const unsigned gen = old / nloc;
        if (old + 1u == (gen + 1u) * nloc) {
            __builtin_amdgcn_fence(__ATOMIC_RELEASE, "agent");
            asm volatile("s_waitcnt vmcnt(0)" ::: "memory");
            const unsigned og = xb_add(&bar[XB_TOP], 1u);
            const unsigned tg = og / nx;
            if (og + 1u == (tg + 1u) * nx) xb_add(&bar[XB_TOPGEN], 1u);
            else XB_SPIN(xb_ld(&bar[XB_TOPGEN]) == tg, bar);
            __builtin_amdgcn_fence(__ATOMIC_ACQUIRE, "agent");
            xb_add(&bar[XB_XGEN(b.x)], 1u);
            asm volatile("s_waitcnt vmcnt(0)" ::: "memory");
        } else {
            XB_SPIN(xb_ld(&bar[XB_XGEN(b.x)]) == gen, bar);
            __builtin_amdgcn_fence(__ATOMIC_ACQUIRE, "agent");
            asm volatile("s_waitcnt vmcnt(0)" ::: "memory");
        }
    }
    __syncthreads();
}
#ifndef MK_USE_CG
#define MK_USE_CG 0
#endif
#if MK_USE_CG
#define GRID_SETUP() do {} while (0)
#define GRID_SYNC() cg::this_grid().sync()
#else
#define GRID_SETUP() volatile LAS unsigned* xb_st = (volatile LAS unsigned*)(F.lds + MISC_OFF); \
    if (F.tid < 2) xb_st[F.tid] = 0u; __syncthreads(); \
    XcdBarrier xbar; xbar.bar = (unsigned*)A.ws + CW_BAR; xbar.x = 0; xbar.st = xb_st; \
    if (hi - lo > 1) xbar = xcd_barrier_post((unsigned*)A.ws + CW_BAR, xb_st)
#define GRID_SYNC() xcd_barrier(xbar)
#endif

__global__ void __launch_bounds__(NTHREADS, 2) fwd_kernel(Args A) {
    extern __shared__ __attribute__((aligned(16))) unsigned char lds_raw[];
    Frame F;
    F.lds = (LAS unsigned char*)lds_raw;
    F.tid = threadIdx.x; F.lane = F.tid & 63; F.wave = __builtin_amdgcn_readfirstlane(F.tid >> 6);
    F.G = gridDim.x; { const int bx = blockIdx.x; F.vcu = (F.G % 8 == 0) ? (bx % 8) * (F.G / 8) + bx / 8 : bx; }
    const int lo = A.ph_lo, hi = A.ph_hi;
#define IN(k) (lo <= (k) && (k) < hi)
#define SEAM(k) do { if (IN(k) && IN((k) + 1)) { GRID_SYNC(); } } while (0)
    GRID_SETUP();
    if (hi - lo > 1 && F.tid == 0) xb_add((unsigned*)A.ws + CW_XCCTAB + F.vcu, xbar.x + 1u);
    const bool fuse01 = IN(0) && IN(1) && F.G == 256 && PROBE_DUP != 0 && PROBE_DUP != 1;
    if (fuse01) { phase0(F, A, 1.0f, true); SEAM(1); }
    else {
    if (IN(0)) { phase0(F, A, 1.0f, false); if (PROBE_DUP == 0) { __syncthreads(); phase0(F, A, 0.0f, false); } } SEAM(0);
    if (IN(1)) { phase1(F, A); if (PROBE_DUP == 1) { __syncthreads(); phase1(F, A); } } SEAM(1);
    }
    if (IN(2)) {
        {
          pg8::Gemm g{(const bf16_t*)(A.ws + WS_H8), (const bf16_t*)(A.ws + WS_WT8), M, 4096, D / 2}; pg8::StaticOrder S; S.init(M, 4096, F.G, (int)blockIdx.x);
          pg8::EpiIn<true> E{WSB(WS_AB), WSB(WS_U), WSB(WS_Q), WSB(WS_V), WSB(WS_G), (bf16_t*)A.out, (bf16_t*)A.out + (size_t)M * D, WSF(WS_LOGF), WSF(CTL_LB), 0, 1.0f / 64.0f};
          pg8::gemm_phase<pg8::EpiIn<true>, true, true, true>(F.lds, g, S, E); }
        {
          pg8::Gemm g{WSB(WS_H), WSB(WS_WT_IN) + (size_t)4096 * D, M, 7168, D}; pg8::StaticOrder S; S.init(M, 7168, F.G, (int)blockIdx.x);
          pg8::EpiIn<false> E{WSB(WS_AB), WSB(WS_U), WSB(WS_Q), WSB(WS_V), WSB(WS_G), (bf16_t*)A.out, (bf16_t*)A.out + (size_t)M * D, WSF(WS_LOGF), WSF(CTL_LB), 16, 1.0f};
          pg8::gemm_phase<pg8::EpiIn<false>, true, true>(F.lds, g, S, E); }
    } SEAM(2);
    if (IN(3) && IN(4) && F.G == 256 && PROBE_DUP != 3 && PROBE_DUP != 4) { phase3ab_fused(F, A, xbar.x + 1u); SEAM(4); }
    else {
    if (IN(3)) { phase3a(F, A); if (PROBE_DUP == 3) phase3a(F, A); } SEAM(3);
    if (IN(4)) { phase3b(F, A); if (PROBE_DUP == 4) phase3b(F, A); } SEAM(4);
    }
    if (IN(5)) { pg8::Gemm g{WSB(WS_ZO), WSB(WS_WT_M), M, D, D}; pg8::StaticOrder S; S.init(M, D, F.G, (int)blockIdx.x);
        pg8::EpiMerge E{(const bf16_t*)A.out, (const bf16_t*)A.out + (size_t)M * D, WSB(WS_H)};
        pg8::gemm_phase<pg8::EpiMerge, true, true>(F.lds, g, S, E); if (PROBE_DUP == 5) pg8::gemm_phase<pg8::EpiMerge, true, true>(F.lds, g, S, E); } SEAM(5);
    if (IN(6)) { pg8::Gemm g{WSB(WS_H), WSB(WS_WT_O), M, D, D}; pg8::StaticOrder S; S.init(M, D, F.G, (int)blockIdx.x);
        pg8::EpiWo E{A.in[0], WSF(CTL_MOD), A.in[12], WSB(WS_X1), (bf16_t*)A.out, WSF(CTL_RSS1), 1.0f};
        pg8::gemm_phase<pg8::EpiWo, true, true>(F.lds, g, S, E);
        if (PROBE_DUP == 6) { pg8::EpiWo E2 = E; E2.amul = 0.0f; pg8::gemm_phase<pg8::EpiWo, true, true>(F.lds, g, S, E2); } } SEAM(6);
    if (IN(7)) { pg8::Gemm g{(const bf16_t*)A.out, WSB(WS_WT_GU), M, 2 * D_FF, D}; pg8::StaticOrder S; S.init(M, 2 * D_FF, F.G, (int)blockIdx.x);
        pg8::EpiFfn E{WSF(CTL_RSS1), WSF(CTL_BIASGU), WSB(WS_ACT)};
        pg8::gemm_phase<pg8::EpiFfn, true, true>(F.lds, g, S, E); if (PROBE_DUP == 7) pg8::gemm_phase<pg8::EpiFfn, true, true>(F.lds, g, S, E); } SEAM(7);
    const int fuse_norm = (F.G == 256) && (PROBE_DUP != 8);
    if (IN(8)) { pg8::Gemm g{WSB(WS_ACT), WSB(WS_WT_D), M, D, D_FF}; pg8::StaticOrder S; S.init(M, D, F.G, (int)blockIdx.x);
        pg8::EpiDown E{WSB(WS_X1), WSF(CTL_MOD), A.in[16], A.out, WSF(CTL_RSS2), (unsigned*)A.ws + CW_PANEL, 1.0f, fuse_norm};
        pg8::gemm_phase<pg8::EpiDown, true, true>(F.lds, g, S, E);
        if (PROBE_DUP == 8) { pg8::EpiDown E2 = E; E2.amul = 0.0f; pg8::gemm_phase<pg8::EpiDown, true, true>(F.lds, g, S, E2); } }
    if (!fuse_norm) { SEAM(8); if (IN(9)) { phase8(F, A); } }
#undef IN
#undef SEAM
}

constexpr int NPHASES = 10;
extern "C" void kernel_launch(void* const* d_in, const int* in_sizes, int n_in, void* d_out, int out_size, void* d_ws, size_t ws_size, hipStream_t stream) {
    static int grid = 0;
    if (grid == 0) {
        if (n_in != 17 || in_sizes[0] != M * D || out_size != M * D || ws_size < WS_END) { fprintf(stderr, "kernel_launch: unexpected shapes (n_in %d, in0 %d, out %d, ws %zu)\n", n_in, n_in > 0 ? in_sizes[0] : -1, out_size, ws_size); grid = -1; return; }
        int dev = 0, cus = 0, per_cu = 0;
        if (hipGetDevice(&dev) != hipSuccess || hipDeviceGetAttribute(&cus, hipDeviceAttributeMultiprocessorCount, dev) != hipSuccess) { grid = -1; return; }
        if (hipFuncSetAttribute((const void*)fwd_kernel, hipFuncAttributeMaxDynamicSharedMemorySize, LDS_BYTES) != hipSuccess) { fprintf(stderr, "kernel_launch: hipFuncSetAttribute failed\n"); grid = -1; return; }
        if (hipOccupancyMaxActiveBlocksPerMultiprocessor(&per_cu, (const void*)fwd_kernel, NTHREADS, LDS_BYTES) != hipSuccess || per_cu < 1) { fprintf(stderr, "kernel_launch: occupancy query says %d\n", per_cu); (void)hipGetLastError(); grid = -1; return; }
        grid = cus;
    }
    if (grid < 0) return;
    (void)hipMemsetAsync((char*)d_ws + WS_CTL, 0, CTL_BIASGU + (size_t)BATCH * 2 * D_FF * sizeof(float), stream);
    Args a{};
    for (int i = 0; i < 17; ++i) a.in[i] = (const float*)d_in[i];
    a.out = (float*)d_out; a.ws = (unsigned char*)d_ws;
    if (MK_N_LAUNCHES == 1) {
        a.ph_lo = 0; a.ph_hi = NPHASES;
        void* kargs[] = {&a};
        hipError_t e = hipLaunchCooperativeKernel((const void*)fwd_kernel, dim3(grid), dim3(NTHREADS), kargs, LDS_BYTES, stream);
        if (e != hipSuccess) fprintf(stderr, "kernel_launch: cooperative launch failed: %s (grid %d)\n", hipGetErrorString(e), grid);
    } else {
        for (int p = 0; p < NPHASES; ++p) { a.ph_lo = p; a.ph_hi = p + 1; hipLaunchKernelGGL(fwd_kernel, dim3(grid), dim3(NTHREADS), LDS_BYTES, stream, a); }
    }
}
```

```cpp
#include <hip/hip_runtime.h>
#include <hip/hip_cooperative_groups.h>
#include <cstdio>
#include <cstdint>
namespace cg = cooperative_groups;

#ifndef MK_N_LAUNCHES
#define MK_N_LAUNCHES 1
#endif

#ifndef PROBE_DUP
#define PROBE_DUP -1
#endif

#define LAS __attribute__((address_space(3)))
typedef unsigned short bf16_t;
typedef short bf16x8 __attribute__((ext_vector_type(8)));
typedef float f32x4 __attribute__((ext_vector_type(4)));
typedef float f32x2 __attribute__((ext_vector_type(2)));
typedef unsigned u32x4 __attribute__((ext_vector_type(4)));
typedef unsigned u32x2 __attribute__((ext_vector_type(2)));
typedef unsigned short u16x4 __attribute__((ext_vector_type(4)));
typedef int i32x8 __attribute__((ext_vector_type(8)));
typedef int i32x4_ __attribute__((ext_vector_type(4)));

constexpr int D = 2048, BATCH = 4, SEQ = 4096, M = BATCH * SEQ;
constexpr int DC = 1024, HK = 1024, HV = 1024, NH = 8, CHUNK = 64, NCHUNK = SEQ / CHUNK;
constexpr int D_IN = 11264, D_FF = 5632, NMOD = 6 * D;
constexpr float EPS = 1e-6f;

constexpr size_t MiB = 1u << 20;
constexpr size_t WS_CTL = 0;
constexpr size_t CTL_MOD = 65536, CTL_RSS1 = 262144, CTL_RSS2 = 327680, CTL_ZERO_BYTES = 393216;
constexpr size_t CTL_LB = 393216, CTL_BIASGU = 397312;
constexpr int CW_BAR = 4096, CW_PANEL = 8192, CW_HEAD = 12288, CW_MODDONE = 14336;
constexpr size_t WS_WT_IN = 2 * MiB, WS_WT_GU = 46 * MiB, WS_WT_D = 90 * MiB, WS_WT_M = 112 * MiB, WS_WT_O = 120 * MiB;
constexpr size_t WS_H = 128 * MiB;
constexpr size_t WS_AB = 192 * MiB, WS_U = 224 * MiB, WS_Q = 256 * MiB, WS_V = 288 * MiB, WS_G = 320 * MiB, WS_LOGF = 352 * MiB, WS_ZO = 416 * MiB;
constexpr size_t WS_ACT = 192 * MiB;
constexpr size_t WS_X1 = 368 * MiB;
constexpr size_t WS_WT8 = 496 * MiB;
constexpr size_t WS_H8 = 416 * MiB;
constexpr size_t WS_END = 512 * MiB;

__device__ __forceinline__ float bf2f(unsigned h) { return __uint_as_float(h << 16); }
__device__ __forceinline__ unsigned cvt_pk_bf16(float lo, float hi) { unsigned r; asm volatile("v_cvt_pk_bf16_f32 %0, %1, %2" : "=v"(r) : "v"(lo), "v"(hi)); return r; }
__device__ __forceinline__ unsigned pack4_fp8(float a, float b, float c, float d) {
    a = __builtin_amdgcn_fmed3f(a, -448.f, 448.f); b = __builtin_amdgcn_fmed3f(b, -448.f, 448.f); c = __builtin_amdgcn_fmed3f(c, -448.f, 448.f); d = __builtin_amdgcn_fmed3f(d, -448.f, 448.f);
    int p = 0; p = __builtin_amdgcn_cvt_pk_fp8_f32(a, b, p, false); p = __builtin_amdgcn_cvt_pk_fp8_f32(c, d, p, true); return (unsigned)p; }
__device__ __forceinline__ float fast_rcp(float x) { return __builtin_amdgcn_rcpf(x); }
__device__ __forceinline__ float fast_exp(float x) { return __builtin_amdgcn_exp2f(x * 1.44269504089f); }
__device__ __forceinline__ float fast_log(float x) { return __builtin_amdgcn_logf(x) * 0.69314718056f; }
__device__ __forceinline__ float sigmoidf_(float x) { return fast_rcp(1.0f + fast_exp(-x)); }
__device__ __forceinline__ float siluf_(float x) { return x * sigmoidf_(x); }
__device__ __forceinline__ float wave_sum(float v) {
#pragma unroll
    for (int o = 1; o < 64; o <<= 1) v += __shfl_xor(v, o);
    return v;
}

namespace pg8 {
constexpr int BM = 256, BK = 64, HALF = 128, HTB = HALF * BK * 2, STAGE_BYTES = 8 * HTB, NXCD = 8, WGM = 8;
__host__ __device__ __forceinline__ int lds_byte(int r, int c) { return r * 128 + ((((c >> 3) ^ (r >> 1)) & 7) << 4) + (c & 7) * 2; }
__host__ __device__ __forceinline__ void stage_rc(int b, int& R, int& C) { R = b >> 7; C = ((((b >> 4) & 7) ^ (R >> 1)) & 7) * 8; }
__host__ __device__ __forceinline__ int perm32(int rho) { const int n = rho >> 4, i = rho & 15; return 8 * (i >> 2) + 4 * n + (i & 3); }

struct Unit { int pm, pn; };
struct Gemm { const bf16_t* A; const bf16_t* Bt; int M, N, K; };

struct StaticOrder {
    int nM, nN, nwg, G, c;
    __host__ __device__ void init(int M_, int N_, int G_, int c_) { nM = M_ / BM; nN = N_ / BM; nwg = nM * nN; G = G_; c = c_; }
    __host__ __device__ bool next(int i, Unit& u) const {
        const long L = (long)i * G + c; if (L >= nwg) return false;
        if (nN == 16 && nM == 64 && G == 256) {
            const int x = c & 7, j = c >> 3; u.pm = 8 * x + 4 * (i & 1) + (j & 3); u.pn = 8 * (i >> 1) + (j >> 2); return true; }
        if (nN == 28 && nM == 64 && G == 256) {
            const int x = c & 7, j = c >> 3;
            if (i < 6) { u.pm = 8 * x + 4 * (i & 1) + (j & 3); u.pn = 8 * (i >> 1) + (j >> 2); } else { u.pm = 8 * x + (j & 7); u.pn = 24 + (j >> 3); }
            return true; }
        if (nN == 44 && nM == 64 && G == 256) {
            const int x = c & 7, j = c >> 3;
            if (i < 10) { u.pm = 8 * x + 4 * (i & 1) + (j & 3); u.pn = 8 * (i >> 1) + (j >> 2); } else { u.pm = 8 * x + (j & 7); u.pn = 40 + (j >> 3); }
            return true; }
        if (nN == 8 && nM == 64 && G == 256) {
            const int x = c & 7, j = c >> 3; u.pm = 8 * x + 4 * i + (j & 3); u.pn = j >> 2; return true; }
        int wgid = (int)L; { const int q = nwg / NXCD, r = nwg % NXCD, xcd = wgid % NXCD, off = wgid / NXCD; wgid = (xcd < r ? xcd * (q + 1) : r * (q + 1) + (xcd - r) * q) + off; }
        const int nig = WGM * nN, gid = wgid / nig, fm = gid * WGM, gsz = (nM - fm) < WGM ? (nM - fm) : WGM;
        u.pm = fm + ((wgid % nig) % gsz); u.pn = (wgid % nig) / gsz; return true;
    }
};

template <class Epi, bool ALIGN_EPI, bool SP2, bool FP8 = false>
__device__ __forceinline__ void gemm_phase(LAS unsigned char* lds, const Gemm g, const StaticOrder& S, const Epi& E) {
    int tid_ = threadIdx.x; asm volatile("" : "+v"(tid_));
    const int tid = tid_, wid = __builtin_amdgcn_readfirstlane(tid >> 6), lane = tid & 63, wr = wid >> 2, wc = wid & 3, fr = lane & 15, fq = lane >> 4;
    const int K = g.K, nt = K / BK;
    unsigned voffA, voffB;
    { int R, C; stage_rc(tid * 16, R, C); const int Rb = (R & ~31) + perm32(R & 31);
        voffA = (unsigned)(R * K + C) * 2u; voffB = (unsigned)(Rb * K + C) * 2u; }
    const size_t qstep = (size_t)64 * K * 2;
    const size_t kstep = (size_t)(BK * 2);
    const size_t hstep = (size_t)HALF * K * 2;
    const size_t tstep = 2 * hstep;
    const unsigned ldsw = (unsigned)wid * 1024u;
    const int aoffk[2] = {lds_byte(wr * 64 + fr, fq * 8), lds_byte(wr * 64 + fr, 32 + fq * 8)}, boffk[2] = {lds_byte(wc * 32 + fr, fq * 8), lds_byte(wc * 32 + fr, 32 + fq * 8)};
#define PG8_SA(b, h) (((b) * 2 + (h)) * HTB)
#define PG8_SB(b, h) ((4 + (b) * 2 + (h)) * HTB)
#define PG8_STAGE(bufoff, gbase, voff) do { _Pragma("unroll") for (int _i = 0; _i < 2; ++_i) \
        __builtin_amdgcn_global_load_lds((const unsigned*)((const char*)(gbase) + _i * qstep + (voff)), (LAS unsigned*)(lds + (bufoff) + ldsw + _i * 8192), 16, 0, 0); } while (0)
#define PG8_LDA(dst, b, h) do { if constexpr (FP8) { _Pragma("unroll") for (int m = 0; m < 4; ++m) dst##8[m] = __builtin_shufflevector(*(const LAS i32x4_*)(lds + PG8_SA(b, h) + aoffk[0] + m * 2048), *(const LAS i32x4_*)(lds + PG8_SA(b, h) + aoffk[1] + m * 2048), 0, 1, 2, 3, 4, 5, 6, 7); } \
        else { _Pragma("unroll") for (int m = 0; m < 4; ++m) _Pragma("unroll") for (int k = 0; k < 2; ++k) dst[m][k] = *(const LAS bf16x8*)(lds + PG8_SA(b, h) + aoffk[k] + m * 2048); } } while (0)
#define PG8_LDB(dst, b, h) do { if constexpr (FP8) { _Pragma("unroll") for (int n = 0; n < 2; ++n) dst##8[n] = __builtin_shufflevector(*(const LAS i32x4_*)(lds + PG8_SB(b, h) + boffk[0] + n * 2048), *(const LAS i32x4_*)(lds + PG8_SB(b, h) + boffk[1] + n * 2048), 0, 1, 2, 3, 4, 5, 6, 7); } \
        else { _Pragma("unroll") for (int n = 0; n < 2; ++n) _Pragma("unroll") for (int k = 0; k < 2; ++k) dst[n][k] = *(const LAS bf16x8*)(lds + PG8_SB(b, h) + boffk[k] + n * 2048); } } while (0)
#define PG8_MMA(ai, bj, At, Bt) do { __builtin_amdgcn_s_setprio(1); \
        if constexpr (FP8) { _Pragma("unroll") for (int m = 0; m < 4; ++m) _Pragma("unroll") for (int n = 0; n < 2; ++n) \
            asm volatile("v_mfma_scale_f32_16x16x128_f8f6f4 %0, %1, %2, %0, %3, %3 op_sel_hi:[0,0,0]" : "+v"(acc[ai][bj][m][n]) : "v"(Bt##8[n]), "v"(At##8[m]), "v"(one_scale)); } \
        else { _Pragma("unroll") for (int m = 0; m < 4; ++m) _Pragma("unroll") for (int n = 0; n < 2; ++n) _Pragma("unroll") for (int k = 0; k < 2; ++k) \
            acc[ai][bj][m][n] = __builtin_amdgcn_mfma_f32_16x16x32_bf16(Bt[n][k], At[m][k], acc[ai][bj][m][n], 0, 0, 0); } \
        __builtin_amdgcn_s_setprio(0); } while (0)
#define PG8_WAIT_V(n) asm volatile("s_waitcnt vmcnt(" #n ")" ::: "memory")
#define PG8_WAIT_L(n) asm volatile("s_waitcnt lgkmcnt(" #n ")" ::: "memory")
#define PG8_BAR __builtin_amdgcn_s_barrier()
#define PG8_SCHED __builtin_amdgcn_sched_barrier(0)
    Unit cur, nxt; int ui = 0;
    if (!S.next(0, cur)) return;
    f32x4 acc[2][2][4][2];
#pragma unroll
    for (int a = 0; a < 2; ++a)
#pragma unroll
        for (int b = 0; b < 2; ++b)
#pragma unroll
            for (int m = 0; m < 4; ++m)
#pragma unroll
                for (int n = 0; n < 2; ++n) acc[a][b][m][n] = (f32x4){0.f, 0.f, 0.f, 0.f};
    const int one_scale = 0x7f7f7f7f;
    bf16x8 At[4][2], B0[2][2], B1[2][2]; i32x8 At8[4], B08[2], B18[2];
    const char* cA = (const char*)g.A + (size_t)cur.pm * tstep; const char* cB = (const char*)g.Bt + (size_t)cur.pn * tstep;
    if constexpr (SP2) {
        PG8_STAGE(PG8_SB(0, 0), cB, voffB); PG8_STAGE(PG8_SB(0, 1), cB + hstep, voffB); PG8_STAGE(PG8_SA(0, 0), cA, voffA); PG8_STAGE(PG8_SA(0, 1), cA + hstep, voffA);
        if (wr == 1) PG8_BAR;
        PG8_WAIT_V(2); PG8_BAR;
        PG8_STAGE(PG8_SB(1, 0), cB + kstep, voffB); PG8_STAGE(PG8_SA(1, 0), cA + kstep, voffA); PG8_STAGE(PG8_SB(1, 1), cB + hstep + kstep, voffB);
        PG8_WAIT_V(6); PG8_BAR;
    } else {
        PG8_STAGE(PG8_SB(0, 0), cB, voffB); PG8_STAGE(PG8_SA(0, 0), cA, voffA); PG8_STAGE(PG8_SB(0, 1), cB + hstep, voffB); PG8_STAGE(PG8_SA(0, 1), cA + hstep, voffA);
        if (wr == 1) PG8_BAR;
        PG8_WAIT_V(4); PG8_BAR;
        PG8_STAGE(PG8_SB(1, 0), cB + kstep, voffB); PG8_STAGE(PG8_SA(1, 0), cA + kstep, voffA); PG8_STAGE(PG8_SB(1, 1), cB + hstep + kstep, voffB);
        PG8_WAIT_V(6); PG8_BAR;
    }
    for (;;) {
        const bool has_next = S.next(ui + 1, nxt);
        const char* nA = has_next ? (const char*)g.A + (size_t)nxt.pm * tstep : cA; const char* nB = has_next ? (const char*)g.Bt + (size_t)nxt.pn * tstep : cB;
        for (int t = 0; t < nt; t += 2) {
            const bool last = (t == nt - 2);
            const char* a1 = cA + (size_t)(t + 1) * kstep;
            const char* a2 = last ? nA : cA + (size_t)(t + 2) * kstep; const char* b2 = last ? nB : cB + (size_t)(t + 2) * kstep;
            const char* a3 = a2 + kstep; const char* b3 = b2 + kstep;
            if constexpr (Epi::MIDK) { if (t == nt / 2) { int tl = threadIdx.x; asm volatile("" : "+v"(tl)); const int le = tl & 63; E.mid(acc, cur, wr, wc, le & 15, le >> 4); } }
            if constexpr (SP2) {
            PG8_LDB(B0, 0, 0); PG8_LDB(B1, 0, 1); PG8_SCHED; PG8_LDA(At, 0, 0); PG8_STAGE(PG8_SA(1, 1), a1 + hstep, voffA);
            PG8_WAIT_V(8); PG8_WAIT_L(0); PG8_BAR; PG8_MMA(0, 0, At, B0); PG8_MMA(0, 1, At, B1); PG8_BAR; PG8_SCHED;
            PG8_LDA(At, 0, 1); PG8_STAGE(PG8_SB(0, 0), b2, voffB); PG8_STAGE(PG8_SB(0, 1), b2 + hstep, voffB); PG8_STAGE(PG8_SA(0, 0), a2, voffA);
            PG8_WAIT_V(8); PG8_WAIT_L(0); PG8_BAR; PG8_MMA(1, 0, At, B0); PG8_MMA(1, 1, At, B1); PG8_BAR; PG8_SCHED;
            PG8_LDB(B0, 1, 0); PG8_LDB(B1, 1, 1); PG8_SCHED; PG8_LDA(At, 1, 0); PG8_STAGE(PG8_SA(0, 1), a2 + hstep, voffA);
            PG8_WAIT_V(8); PG8_WAIT_L(0); PG8_BAR; PG8_MMA(0, 0, At, B0); PG8_MMA(0, 1, At, B1); PG8_BAR; PG8_SCHED;
            PG8_LDA(At, 1, 1); PG8_STAGE(PG8_SB(1, 0), b3, voffB); PG8_STAGE(PG8_SB(1, 1), b3 + hstep, voffB); PG8_STAGE(PG8_SA(1, 0), a3, voffA);
            PG8_WAIT_V(8); PG8_WAIT_L(0); PG8_BAR; PG8_MMA(1, 0, At, B0); PG8_MMA(1, 1, At, B1); PG8_BAR; PG8_SCHED;
            } else {
            PG8_LDB(B0, 0, 0); PG8_SCHED; PG8_LDA(At, 0, 0); PG8_STAGE(PG8_SA(1, 1), a1 + hstep, voffA);
            PG8_WAIT_L(8); PG8_BAR; PG8_WAIT_L(0); PG8_MMA(0, 0, At, B0); PG8_BAR; PG8_SCHED;
            PG8_LDB(B1, 0, 1); PG8_STAGE(PG8_SB(0, 0), b2, voffB);
            PG8_BAR; PG8_WAIT_L(0); PG8_MMA(0, 1, At, B1); PG8_BAR;
            PG8_LDA(At, 0, 1); PG8_STAGE(PG8_SA(0, 0), a2, voffA);
            PG8_BAR; PG8_WAIT_L(0); PG8_MMA(1, 0, At, B0); PG8_BAR; PG8_SCHED;
            PG8_STAGE(PG8_SB(0, 1), b2 + hstep, voffB);
            PG8_WAIT_V(6); PG8_BAR; PG8_MMA(1, 1, At, B1); PG8_BAR;
            PG8_LDB(B0, 1, 0); PG8_SCHED; PG8_LDA(At, 1, 0); PG8_STAGE(PG8_SA(0, 1), a2 + hstep, voffA);
            PG8_WAIT_L(8); PG8_BAR; PG8_WAIT_L(0); PG8_MMA(0, 0, At, B0); PG8_BAR; PG8_SCHED;
            PG8_LDB(B1, 1, 1); PG8_STAGE(PG8_SB(1, 0), b3, voffB);
            PG8_BAR; PG8_WAIT_L(0); PG8_MMA(0, 1, At, B1); PG8_BAR;
            PG8_LDA(At, 1, 1); PG8_STAGE(PG8_SA(1, 0), a3, voffA);
            PG8_BAR; PG8_WAIT_L(0); PG8_MMA(1, 0, At, B0); PG8_BAR; PG8_SCHED;
            PG8_STAGE(PG8_SB(1, 1), b3 + hstep, voffB);
            PG8_WAIT_V(6); PG8_BAR; PG8_MMA(1, 1, At, B1); PG8_BAR;
            }
        }
        if constexpr (ALIGN_EPI) { if (wr == 0) PG8_BAR; }
        if constexpr (FP8) asm volatile("s_nop 15\n\ts_nop 15" ::: "memory");
        { int tl = threadIdx.x; asm volatile("" : "+v"(tl));
          const int le = tl & 63; E(acc, cur, wr, wc, le & 15, le >> 4); }
        if (!has_next) break;
#pragma unroll
        for (int a = 0; a < 2; ++a)
#pragma unroll
            for (int b = 0; b < 2; ++b)
#pragma unroll
                for (int m = 0; m < 4; ++m)
#pragma unroll
                    for (int n = 0; n < 2; ++n) acc[a][b][m][n] = (f32x4){0.f, 0.f, 0.f, 0.f};
        cur = nxt; cA = nA; cB = nB; ++ui;
        if constexpr (ALIGN_EPI) { if (wr == 1) PG8_BAR; }
    }
    PG8_WAIT_V(0);
    if constexpr (!ALIGN_EPI) { if (wr == 0) PG8_BAR; }
    PG8_BAR;
#undef PG8_SA
#undef PG8_SB
#undef PG8_STAGE
#undef PG8_LDA
#undef PG8_LDB
#undef PG8_MMA
#undef PG8_WAIT_V
#undef PG8_WAIT_L
#undef PG8_BAR
#undef PG8_SCHED
}

typedef f32x4 Acc[2][2][4][2];
__device__ __forceinline__ f32x4 ffn_scale(const f32x4 gg, const f32x4 sc) { f32x4 r;
#pragma unroll
    for (int j = 0; j < 4; ++j) { const float v = gg[j] * (sc[j] + 1.0f); r[j] = __builtin_copysignf(fmaxf(__builtin_fabsf(v), 1e-30f), v); }
    return r; }
__device__ __forceinline__ unsigned pack4_u8(float a, float b, float c, float d) {
    unsigned p = 0; p = __builtin_amdgcn_cvt_pk_u8_f32(a, 0, p); p = __builtin_amdgcn_cvt_pk_u8_f32(b, 1, p); p = __builtin_amdgcn_cvt_pk_u8_f32(c, 2, p); p = __builtin_amdgcn_cvt_pk_u8_f32(d, 3, p); return p; }
__device__ __forceinline__ void unpack8_u8(const u32x2 w, f32x4& v0, f32x4& v1) {
    v0[0] = (float)(w.x & 0xffu); v0[1] = (float)((w.x >> 8) & 0xffu); v0[2] = (float)((w.x >> 16) & 0xffu); v0[3] = (float)(w.x >> 24);
    v1[0] = (float)(w.y & 0xffu); v1[1] = (float)((w.y >> 8) & 0xffu); v1[2] = (float)((w.y >> 16) & 0xffu); v1[3] = (float)(w.y >> 24); }
__device__ __forceinline__ u32x4 pack8(const f32x4 v0, const f32x4 v1) {
    u32x4 w; w.x = cvt_pk_bf16(v0[0], v0[1]); w.y = cvt_pk_bf16(v0[2], v0[3]); w.z = cvt_pk_bf16(v1[0], v1[1]); w.w = cvt_pk_bf16(v1[2], v1[3]); return w;
}
__device__ __forceinline__ void unpack8(const u32x4 w, f32x4& v0, f32x4& v1) {
    v0[0] = __uint_as_float(w.x << 16); v0[1] = __uint_as_float(w.x & 0xffff0000u); v0[2] = __uint_as_float(w.y << 16); v0[3] = __uint_as_float(w.y & 0xffff0000u);
    v1[0] = __uint_as_float(w.z << 16); v1[1] = __uint_as_float(w.z & 0xffff0000u); v1[2] = __uint_as_float(w.w << 16); v1[3] = __uint_as_float(w.w & 0xffff0000u);
}

template <bool GATES> struct EpiIn {
    static constexpr bool MIDK = false;
    bf16_t *AB, *U, *Q, *V, *G; unsigned char *R, *GB; bf16_t* LOGF; const float* lb; int pn_off; float ascale;
    __device__ __forceinline__ void mid(Acc&, const Unit&, int, int, int, int) const {}
    __device__ __forceinline__ void operator()(Acc& acc, const Unit& u, int wr, int wc, int fr, int fq) const {
        asm volatile("" : "+v"(fr), "+v"(fq));
        const int pn = u.pn + pn_off; const int row0 = u.pm * BM + wr * 64 + fr; const int cw = wc * 32 + 8 * fq;
        if (GATES) {
            const int col = 128 * pn + cw;
#pragma unroll
            for (int ai = 0; ai < 2; ++ai)
#pragma unroll
                for (int m = 0; m < 4; ++m) { const size_t o = (size_t)(row0 + ai * HALF + m * 16) * D + col;
                    f32x4 r[2], gbv[2];
#pragma unroll
                    for (int n = 0; n < 2; ++n)
#pragma unroll
                        for (int j = 0; j < 4; ++j) { float a = acc[ai][0][m][n][j] * ascale, b = acc[ai][1][m][n][j] * ascale;
                            const float ea = 1.0f + fast_exp(-a), eb = 1.0f + fast_exp(-b); const float ia = fast_rcp(ea), ib = fast_rcp(eb);
                            r[n][j] = __builtin_rintf(255.0f * ia); gbv[n][j] = fmaxf(__builtin_rintf(255.0f * ib), 1.0f); }
                    u32x2 wa, wb; wa.x = pack4_u8(r[0][0], r[0][1], r[0][2], r[0][3]); wa.y = pack4_u8(r[1][0], r[1][1], r[1][2], r[1][3]);
                    wb.x = pack4_u8(gbv[0][0], gbv[0][1], gbv[0][2], gbv[0][3]); wb.y = pack4_u8(gbv[1][0], gbv[1][1], gbv[1][2], gbv[1][3]);
                    *(u32x2*)(R + o) = wa; *(u32x2*)(GB + o) = wb; }
        } else if (!GATES && pn >= 20 && pn < 28) {
            const int col = 128 * (pn - 20) + cw;
#pragma unroll
            for (int ai = 0; ai < 2; ++ai)
#pragma unroll
                for (int m = 0; m < 4; ++m) { const size_t o = (size_t)(row0 + ai * HALF + m * 16) * DC + col;
                    *(u32x4*)(U + o) = pack8(acc[ai][0][m][0] * acc[ai][1][m][0], acc[ai][0][m][1] * acc[ai][1][m][1]); }
        } else if (!GATES && pn >= 36 && pn < 40) {
            const int colt = 256 * (pn - 36) + cw;
#pragma unroll
            for (int bj = 0; bj < 2; ++bj) { const int col = colt + bj * HALF;
                const f32x4 l0 = *(const f32x4*)(lb + col), l1 = *(const f32x4*)(lb + col + 4);
#pragma unroll
                for (int ai = 0; ai < 2; ++ai)
#pragma unroll
                    for (int m = 0; m < 4; ++m) { bf16_t* o = LOGF + (size_t)(row0 + ai * HALF + m * 16) * HK + col; f32x4 y0, y1;
#pragma unroll
                        for (int j = 0; j < 4; ++j) { y0[j] = fast_log(l0[j] + (1.0f - l0[j]) * sigmoidf_(acc[ai][bj][m][0][j])); y1[j] = fast_log(l1[j] + (1.0f - l1[j]) * sigmoidf_(acc[ai][bj][m][1][j])); }
                        *(u32x4*)o = pack8(y0, y1); } }
        } else if (!GATES) {
            bf16_t* dst; int colt; bool act;
            if (pn < 20) { dst = AB; colt = 256 * (pn - 16); act = false; }
            else if (pn < 32) { dst = Q; colt = 256 * (pn - 28); act = true; }
            else if (pn < 36) { dst = G; colt = 256 * (pn - 32); act = true; }
            else { dst = V; colt = 256 * (pn - 40); act = false; }
            colt += cw;
#pragma unroll
            for (int ai = 0; ai < 2; ++ai)
#pragma unroll
                for (int m = 0; m < 4; ++m) { bf16_t* rowp = dst + (size_t)(row0 + ai * HALF + m * 16) * 1024 + colt;
#pragma unroll
                    for (int bj = 0; bj < 2; ++bj) { f32x4 v0 = acc[ai][bj][m][0], v1 = acc[ai][bj][m][1];
                        if (act) {
#pragma unroll
                            for (int j = 0; j < 4; ++j) { v0[j] = siluf_(v0[j]); v1[j] = siluf_(v1[j]); } }
                        *(u32x4*)(rowp + bj * HALF) = pack8(v0, v1); } }
        }
    }
};

struct EpiMerge {
    static constexpr bool MIDK = true;
    const unsigned char *R, *GB; bf16_t* MG;
    __device__ __forceinline__ void mid(Acc& acc, const Unit& u, int wr, int wc, int fr, int fq) const {
        asm volatile("" : "+v"(fr), "+v"(fq));
        const int row0 = u.pm * BM + wr * 64 + fr, col0 = u.pn * BM + wc * 32 + 8 * fq;
#pragma unroll
        for (int ai = 0; ai < 2; ++ai)
#pragma unroll
            for (int m = 0; m < 4; ++m) { const size_t o = (size_t)(row0 + ai * HALF + m * 16) * D + col0;
#pragma unroll
                for (int bj = 0; bj < 2; ++bj) { const u32x2 wa = *(const u32x2*)(R + o + bj * HALF), wb = *(const u32x2*)(GB + o + bj * HALF);
                    f32x4 a0, a1, b0, b1; unpack8_u8(wa, a0, a1); unpack8_u8(wb, b0, b1);
#pragma unroll
                    for (int j = 0; j < 4; ++j) { acc[ai][bj][m][0][j] *= a0[j] * fast_rcp(b0[j]); acc[ai][bj][m][1][j] *= a1[j] * fast_rcp(b1[j]); } } }
    }
    __device__ __forceinline__ void operator()(Acc& acc, const Unit& u, int wr, int wc, int fr, int fq) const {
        asm volatile("" : "+v"(fr), "+v"(fq));
        const int row0 = u.pm * BM + wr * 64 + fr, col0 = u.pn * BM + wc * 32 + 8 * fq;
        u32x2 gb[2][2];
        { const size_t o = (size_t)row0 * D + col0; gb[0][0] = *(const u32x2*)(GB + o); gb[0][1] = *(const u32x2*)(GB + o + HALF); }
#pragma unroll
        for (int it = 0; it < 8; ++it) { const int ai = it >> 2, m = it & 3; const size_t o = (size_t)(row0 + ai * HALF + m * 16) * D + col0;
            if (it < 7) { const size_t o2 = (size_t)(row0 + ((it + 1) >> 2) * HALF + ((it + 1) & 3) * 16) * D + col0; gb[(it + 1) & 1][0] = *(const u32x2*)(GB + o2); gb[(it + 1) & 1][1] = *(const u32x2*)(GB + o2 + HALF); }
#pragma unroll
            for (int bj = 0; bj < 2; ++bj) { f32x4 g0, g1; unpack8_u8(gb[it & 1][bj], g0, g1);
                *(u32x4*)(MG + o + bj * HALF) = pack8(acc[ai][bj][m][0] * (g0 * (1.0f / 255.0f)), acc[ai][bj][m][1] * (g1 * (1.0f / 255.0f))); } }
    }
};

struct EpiWo {
    static constexpr bool MIDK = false;
    const float* x; const float* mod; const float* gffn; bf16_t* X1; bf16_t* X1S; float* rss; float amul;
    __device__ __forceinline__ void mid(Acc&, const Unit&, int, int, int, int) const {}
    __device__ __forceinline__ void operator()(Acc& acc, const Unit& u, int wr, int wc, int fr, int fq) const {
        asm volatile("" : "+v"(fr), "+v"(fq));
        const int row0 = u.pm * BM + wr * 64 + fr, col0 = u.pn * BM + wc * 32 + 8 * fq; const int b = u.pm >> 4;
        const float* mb = mod + (size_t)b * NMOD;
        f32x4 gt[2][2], gm[2][2];
#pragma unroll
        for (int bj = 0; bj < 2; ++bj)
#pragma unroll
            for (int n = 0; n < 2; ++n) { const int c = col0 + bj * HALF + 4 * n; gt[bj][n] = *(const f32x4*)(mb + 2 * D + c);
                const f32x4 s = *(const f32x4*)(mb + 4 * D + c), gg = *(const f32x4*)(gffn + c); gm[bj][n] = ffn_scale(gg, s); }
        f32x4 xb[2][4];
        { const size_t o = (size_t)row0 * D + col0;
#pragma unroll
          for (int q = 0; q < 4; ++q) xb[0][q] = *(const f32x4*)(x + o + (q >> 1) * HALF + 4 * (q & 1)); }
#pragma unroll
        for (int it = 0; it < 8; ++it) { const int ai = it >> 2, m = it & 3; const int row = row0 + ai * HALF + m * 16; const size_t o = (size_t)row * D + col0; float ss = 0.f;
            if (it < 7) { const size_t o2 = (size_t)(row0 + ((it + 1) >> 2) * HALF + ((it + 1) & 3) * 16) * D + col0;
#pragma unroll
                for (int q = 0; q < 4; ++q) xb[(it + 1) & 1][q] = *(const f32x4*)(x + o2 + (q >> 1) * HALF + 4 * (q & 1)); }
#pragma unroll
            for (int bj = 0; bj < 2; ++bj) { f32x4 v[2];
#pragma unroll
                for (int n = 0; n < 2; ++n) { v[n] = xb[it & 1][bj * 2 + n] + gt[bj][n] * acc[ai][bj][m][n];
                    ss += (v[n][0] * v[n][0] + v[n][1] * v[n][1]) + (v[n][2] * v[n][2] + v[n][3] * v[n][3]); }
                *(u32x4*)(X1S + o + bj * HALF) = pack8(v[0] * gm[bj][0], v[1] * gm[bj][1]); }
            ss += __shfl_xor(ss, 16); ss += __shfl_xor(ss, 32);
            if (fq == 0) atomicAdd(rss + row, ss * amul); }
    }
};

struct EpiFfn {
    static constexpr bool MIDK = false;
    const float* rss; const float* bias; bf16_t* ACT;
    __device__ __forceinline__ void mid(Acc&, const Unit&, int, int, int, int) const {}
    __device__ __forceinline__ void operator()(Acc& acc, const Unit& u, int wr, int wc, int fr, int fq) const {
        asm volatile("" : "+v"(fr), "+v"(fq));
        const int row0 = u.pm * BM + wr * 64 + fr, cw = wc * 32 + 8 * fq; const int b = u.pm >> 4;
        const float* bb = bias + (size_t)b * (2 * D_FF) + u.pn * BM + cw;
        f32x4 bg[2], bu[2];
#pragma unroll
        for (int n = 0; n < 2; ++n) { bg[n] = *(const f32x4*)(bb + 4 * n); bu[n] = *(const f32x4*)(bb + HALF + 4 * n); }
        float rs[8];
#pragma unroll
        for (int it = 0; it < 8; ++it) rs[it] = rss[row0 + (it >> 2) * HALF + (it & 3) * 16];
#pragma unroll
        for (int it = 0; it < 8; ++it) rs[it] = rsqrtf(rs[it] * (1.0f / D) + EPS);
#pragma unroll
        for (int ai = 0; ai < 2; ++ai)
#pragma unroll
            for (int m = 0; m < 4; ++m) { const int row = row0 + ai * HALF + m * 16; const float rstd = rs[ai * 4 + m]; f32x4 o[2];
#pragma unroll
                for (int n = 0; n < 2; ++n)
#pragma unroll
                    for (int j = 0; j < 4; ++j) { const float gv = rstd * acc[ai][0][m][n][j] + bg[n][j], uv = rstd * acc[ai][1][m][n][j] + bu[n][j]; o[n][j] = siluf_(gv) * uv; }
                *(u32x4*)(ACT + (size_t)row * D_FF + u.pn * HALF + cw) = pack8(o[0], o[1]); }
    }
};

struct EpiDown {
    static constexpr bool MIDK = false;
    const bf16_t* X1; const float* mod; const float* gfin; float* out; float* rss; unsigned* cnt; float amul; int fused; const float* gffn;
    __device__ __forceinline__ void mid(Acc&, const Unit&, int, int, int, int) const {}
    __device__ __forceinline__ void operator()(Acc& acc, const Unit& u, int wr, int wc, int fr, int fq) const {
        asm volatile("" : "+v"(fr), "+v"(fq));
        const int row0 = u.pm * BM + wr * 64 + fr, col0 = u.pn * BM + wc * 32 + 8 * fq; const int b = u.pm >> 4;
        const float* mb = mod + (size_t)b * NMOD + 5 * D;
        { f32x4 gt[2][2], rs[2][2];
#pragma unroll
          for (int bj = 0; bj < 2; ++bj)
#pragma unroll
            for (int n = 0; n < 2; ++n) { const int c = col0 + bj * HALF + 4 * n; gt[bj][n] = *(const f32x4*)(mb + c);
                const f32x4 sv = ffn_scale(*(const f32x4*)(gffn + c), *(const f32x4*)(mb - D + c));
#pragma unroll
                for (int j = 0; j < 4; ++j) rs[bj][n][j] = fast_rcp(sv[j]); }
          u32x4 xb[2][2];
          { const size_t o = (size_t)row0 * D + col0; xb[0][0] = *(const u32x4*)(X1 + o); xb[0][1] = *(const u32x4*)(X1 + o + HALF); }
#pragma unroll
          for (int ai = 0; ai < 2; ++ai)
#pragma unroll
            for (int m = 0; m < 4; ++m) { const int it = ai * 4 + m; const int row = row0 + ai * HALF + m * 16; float ss = 0.f;
                if (it < 7) { const size_t o2 = (size_t)(row0 + ((it + 1) >> 2) * HALF + ((it + 1) & 3) * 16) * D + col0;
                    xb[(it + 1) & 1][0] = *(const u32x4*)(X1 + o2); xb[(it + 1) & 1][1] = *(const u32x4*)(X1 + o2 + HALF); }
#pragma unroll
                for (int bj = 0; bj < 2; ++bj) { f32x4 xv[2]; unpack8(xb[it & 1][bj], xv[0], xv[1]);
#pragma unroll
                    for (int n = 0; n < 2; ++n) { const f32x4 v = xv[n] * rs[bj][n] + gt[bj][n] * acc[ai][bj][m][n];
                        acc[ai][bj][m][n] = v; ss += (v[0] * v[0] + v[1] * v[1]) + (v[2] * v[2] + v[3] * v[3]); } }
                ss += __shfl_xor(ss, 16); ss += __shfl_xor(ss, 32);
                if (fq == 0) atomicAdd(rss + row, ss * amul); } }
        if (!fused) {
#pragma unroll
            for (int ai = 0; ai < 2; ++ai)
#pragma unroll
                for (int m = 0; m < 4; ++m) { const size_t o = (size_t)(row0 + ai * HALF + m * 16) * D + col0;
#pragma unroll
                    for (int bj = 0; bj < 2; ++bj)
#pragma unroll
                        for (int n = 0; n < 2; ++n) *(f32x4*)(out + o + bj * HALF + 4 * n) = acc[ai][bj][m][n]; }
            return;
        }
        asm volatile("s_waitcnt vmcnt(0)" ::: "memory");
        __builtin_amdgcn_s_barrier();
        if (threadIdx.x == 0) {
            unsigned* cw = cnt + 64 * u.pm;
            __hip_atomic_fetch_add(cw, 1u, __ATOMIC_RELAXED, __HIP_MEMORY_SCOPE_AGENT);
            unsigned sp = 0;
            while (__hip_atomic_load(cw, __ATOMIC_RELAXED, __HIP_MEMORY_SCOPE_AGENT) < 8u) { __builtin_amdgcn_s_sleep(1); if (++sp > (1u << 22)) break; }
            asm volatile("s_waitcnt vmcnt(0)" ::: "memory");
        }
        __builtin_amdgcn_s_barrier();
        asm volatile("" ::: "memory");
        f32x4 gf[2][2];
#pragma unroll
        for (int bj = 0; bj < 2; ++bj)
#pragma unroll
            for (int n = 0; n < 2; ++n) gf[bj][n] = *(const f32x4*)(gfin + col0 + bj * HALF + 4 * n);
#pragma unroll
        for (int ai = 0; ai < 2; ++ai)
#pragma unroll
            for (int m = 0; m < 4; ++m) { const int row = row0 + ai * HALF + m * 16; const size_t o = (size_t)row * D + col0;
                const float rstd = rsqrtf(__hip_atomic_load(rss + row, __ATOMIC_RELAXED, __HIP_MEMORY_SCOPE_AGENT) * (1.0f / D) + EPS);
#pragma unroll
                for (int bj = 0; bj < 2; ++bj)
#pragma unroll
                    for (int n = 0; n < 2; ++n) *(f32x4*)(out + o + bj * HALF + 4 * n) = acc[ai][bj][m][n] * rstd * gf[bj][n]; }
    }
};
}

constexpr int NWAVES = 8, NTHREADS = NWAVES * 64;
constexpr int LDS_BYTES = 147456;
constexpr int MISC_OFF = LDS_BYTES - 64;

struct Args {
    const float* in[17]; float* out; unsigned char* ws; int ph_lo, ph_hi;
};

struct Frame {
    LAS unsigned char* lds;
    int tid, lane, wave, vcu, G;
};
#define WSF(off) ((float*)(A.ws + (off)))
#define WSB(off) ((bf16_t*)(A.ws + (off)))

template <bool BIAS = false>
__device__ __forceinline__ void p0_transpose_item(const float* W, int N, bf16_t* WT, int ldk, int koff, int drow0, LAS float* scr, int k0, int n0, int lane, const LAS f32x4* shf = nullptr, float* bias = nullptr) {
    f32x4 bacc = {0.f, 0.f, 0.f, 0.f};
#pragma unroll 8
    for (int i = 0; i < 32; ++i) { const int kk = 2 * i + (lane >> 5); const float v = __builtin_nontemporal_load(W + (size_t)(k0 + kk) * N + n0 + (lane & 31)); scr[kk * 33 + (lane & 31)] = v;
        if constexpr (BIAS) bacc += shf[k0 + kk] * v; }
    if constexpr (BIAS) {
#pragma unroll
        for (int b = 0; b < 4; ++b) bacc[b] += __shfl_xor(bacc[b], 32);
        const int hb = lane >> 5; float* bp = bias + (size_t)(2 * hb) * (2 * D_FF) + drow0 + (lane & 31);
        atomicAdd(bp, hb ? bacc[2] : bacc[0]); atomicAdd(bp + 2 * D_FF, hb ? bacc[3] : bacc[1]); }
    asm volatile("s_waitcnt lgkmcnt(0)" ::: "memory");
    const int c = lane & 7;
#pragma unroll
    for (int j = 0; j < 4; ++j) { const int n = (lane >> 3) + 8 * j; const LAS float* s = scr + (8 * c) * 33 + n;
        u32x4 o; o.x = cvt_pk_bf16(s[0 * 33], s[1 * 33]); o.y = cvt_pk_bf16(s[2 * 33], s[3 * 33]); o.z = cvt_pk_bf16(s[4 * 33], s[5 * 33]); o.w = cvt_pk_bf16(s[6 * 33], s[7 * 33]);
        *(u32x4*)(WT + (size_t)(drow0 + n) * ldk + koff + k0 + 8 * c) = o; }
    asm volatile("s_waitcnt lgkmcnt(0)" ::: "memory");
}
__device__ __forceinline__ void p0_transpose_item_fp8(const float* W, int N, unsigned char* WT8, int ldk, int drow0, LAS float* scr, int k0, int n0, int lane) {
#pragma unroll 8
    for (int i = 0; i < 32; ++i) { const int kk = 2 * i + (lane >> 5); scr[kk * 33 + (lane & 31)] = __builtin_nontemporal_load(W + (size_t)(k0 + kk) * N + n0 + (lane & 31)); }
    asm volatile("s_waitcnt lgkmcnt(0)" ::: "memory");
    const int c = lane & 3;
#pragma unroll
    for (int j = 0; j < 2; ++j) { const int n = (lane >> 2) + 16 * j; const LAS float* s = scr + (16 * c) * 33 + n; u32x4 o;
        o.x = pack4_fp8(s[0 * 33] * 64.f, s[1 * 33] * 64.f, s[2 * 33] * 64.f, s[3 * 33] * 64.f); o.y = pack4_fp8(s[4 * 33] * 64.f, s[5 * 33] * 64.f, s[6 * 33] * 64.f, s[7 * 33] * 64.f);
        o.z = pack4_fp8(s[8 * 33] * 64.f, s[9 * 33] * 64.f, s[10 * 33] * 64.f, s[11 * 33] * 64.f); o.w = pack4_fp8(s[12 * 33] * 64.f, s[13 * 33] * 64.f, s[14 * 33] * 64.f, s[15 * 33] * 64.f);
        *(u32x4*)(WT8 + (size_t)(drow0 + n) * ldk + k0 + 16 * c) = o; }
    asm volatile("s_waitcnt lgkmcnt(0)" ::: "memory");
}
__device__ __forceinline__ int pair_row(int c, int second) { return 256 * (c >> 7) + 128 * second + (c & 127); }
__device__ __forceinline__ int win_dest_row(int c) {
    if (c < 1024) return 4096 + c;
    if (c < 2048) return 5120 + pair_row(c - 1024, 0);
    if (c < 3072) return 5120 + pair_row(c - 2048, 1);
    if (c < 4096) return 7168 + (c - 3072);
    if (c < 5120) return 9216 + (c - 4096);
    if (c < 6144) return 10240 + (c - 5120);
    if (c < 7168) return 8192 + (c - 6144);
    if (c < 9216) return pair_row(c - 7168, 0);
    return pair_row(c - 9216, 1);
}

__device__ __forceinline__ void phase1_rows(Frame& F, const Args& A);
__device__ __forceinline__ void phase0(Frame& F, const Args& A, float amul, bool fused) {
    const float* c_in = A.in[1]; const float* w_ada = A.in[2]; const float* b_ada = A.in[3]; const float* lb_param = A.in[7];
    float* MOD = WSF(CTL_MOD); float* LBp = WSF(CTL_LB);
    LAS float* sc = (LAS float*)(F.lds);
    LAS float* red = (LAS float*)(F.lds + 32768);
    for (int i = F.tid; i < BATCH * D; i += NTHREADS) { const float v = c_in[i]; sc[i] = v / (1.0f + __expf(-v)); }
    __syncthreads();
    for (int it = F.vcu; it < 768; it += F.G) {
        const int cb = it % 48, kc = it / 48; const int k0 = kc * 128 + F.wave * 16, col = cb * 256 + F.lane * 4;
        f32x4 a[4] = {{0.f, 0.f, 0.f, 0.f}, {0.f, 0.f, 0.f, 0.f}, {0.f, 0.f, 0.f, 0.f}, {0.f, 0.f, 0.f, 0.f}};
#pragma unroll 4
        for (int kk = 0; kk < 16; ++kk) { const f32x4 w4 = __builtin_nontemporal_load((const f32x4*)(w_ada + (size_t)(k0 + kk) * NMOD + col));
#pragma unroll
            for (int b = 0; b < 4; ++b) a[b] += w4 * sc[b * D + k0 + kk]; }
#pragma unroll
        for (int b = 0; b < 4; ++b) *(LAS f32x4*)(red + (F.wave * 4 + b) * 256 + F.lane * 4) = a[b];
        __syncthreads();
#pragma unroll
        for (int r = 0; r < 2; ++r) { const int o = F.tid + r * NTHREADS, b = o >> 8, ci = o & 255; float s = 0.f;
#pragma unroll
            for (int w = 0; w < 8; ++w) s += red[(w * 4 + b) * 256 + ci];
            if (kc == 0) s += b_ada[cb * 256 + ci];
            atomicAdd(MOD + (size_t)b * NMOD + cb * 256 + ci, s * amul); }
        __syncthreads();
    }
    if (fused) { asm volatile("s_waitcnt vmcnt(0)" ::: "memory"); __syncthreads();
        if (F.tid == 0)
            __hip_atomic_fetch_add((unsigned*)A.ws + CW_MODDONE, 1u, __ATOMIC_RELAXED, __HIP_MEMORY_SCOPE_AGENT); }
    if (F.vcu == F.G - 1) for (int i = F.tid; i < HK; i += NTHREADS) LBp[i] = 1.0f / (1.0f + __expf(lb_param[HK + i] - lb_param[i]));
    LAS float* scr = (LAS float*)(F.lds + 65536 + F.wave * 8448);
    const int gw = F.vcu * NWAVES + F.wave, NGW = F.G * NWAVES;
    constexpr int I_IN = (D / 64) * (7168 / 32), I_G8 = (D / 64) * (4096 / 32), I_G = (D / 64) * (D_FF / 32), I_D = (D_FF / 64) * (D / 32), I_C = (DC / 64) * (D / 32), I_O = (D / 64) * (D / 32);
    constexpr int NITEMS = I_IN + I_G8 + 2 * I_G + I_D + 2 * I_C + I_O;
    int it = gw;
    for (; it < I_D + I_O + 2 * I_C; it += NGW) {
        int r = it;
        if (r < I_D) { const int nb = D / 32, k0 = 64 * (r / nb), n0 = 32 * (r % nb); p0_transpose_item(A.in[15], D, WSB(WS_WT_D), D_FF, 0, n0, scr, k0, n0, F.lane); continue; } r -= I_D;
        if (r < I_O) { const int nb = D / 32, k0 = 64 * (r / nb), n0 = 32 * (r % nb); p0_transpose_item(A.in[11], D, WSB(WS_WT_O), D, 0, n0, scr, k0, n0, F.lane); continue; } r -= I_O;
        if (r < I_C) { const int nb = D / 32, k0 = 64 * (r / nb), n0 = 32 * (r % nb); p0_transpose_item(A.in[9], D, WSB(WS_WT_M), D, 0, n0, scr, k0, n0, F.lane); continue; } r -= I_C;
        { const int nb = D / 32, k0 = 64 * (r / nb), n0 = 32 * (r % nb); p0_transpose_item(A.in[10], D, WSB(WS_WT_M), D, DC, n0, scr, k0, n0, F.lane); }
    }
    const LAS f32x4* shf = (const LAS f32x4*)(F.lds);
    if (fused) { __syncthreads();
        if (F.tid == 0) { unsigned* cw = (unsigned*)A.ws + CW_MODDONE; unsigned sp = 0;
            __builtin_amdgcn_fence(__ATOMIC_ACQUIRE, "agent");
            while (__hip_atomic_load(cw, __ATOMIC_RELAXED, __HIP_MEMORY_SCOPE_AGENT) < (unsigned)F.G) { __builtin_amdgcn_s_sleep(2); if (++sp > (1u << 22)) break; }
            asm volatile("s_waitcnt vmcnt(0)" ::: "memory"); }
        __syncthreads();
        for (int i = F.tid; i < D; i += NTHREADS) { f32x4 v; v[0] = MOD[0 * (size_t)NMOD + 3 * D + i]; v[1] = MOD[1 * (size_t)NMOD + 3 * D + i]; v[2] = MOD[2 * (size_t)NMOD + 3 * D + i]; v[3] = MOD[3 * (size_t)NMOD + 3 * D + i];
            ((LAS f32x4*)(F.lds))[i] = v; }
        __syncthreads(); }
    for (; it < NITEMS; it += NGW) {
        int r = it;
        if (fused) { int q = r - (I_D + I_O + 2 * I_C);
            if (q < I_G) { const int nb = D_FF / 32, k0 = 64 * (q / nb), n0 = 32 * (q % nb); p0_transpose_item<true>(A.in[13], D_FF, WSB(WS_WT_GU), D, 0, pair_row(n0, 0), scr, k0, n0, F.lane, shf, WSF(CTL_BIASGU)); continue; } q -= I_G;
            if (q < I_G) { const int nb = D_FF / 32, k0 = 64 * (q / nb), n0 = 32 * (q % nb); p0_transpose_item<true>(A.in[14], D_FF, WSB(WS_WT_GU), D, 0, pair_row(n0, 1), scr, k0, n0, F.lane, shf, WSF(CTL_BIASGU)); continue; } }
        if (r < I_D) { const int nb = D / 32, k0 = 64 * (r / nb), n0 = 32 * (r % nb); p0_transpose_item(A.in[15], D, WSB(WS_WT_D), D_FF, 0, n0, scr, k0, n0, F.lane); continue; } r -= I_D;
        if (r < I_O) { const int nb = D / 32, k0 = 64 * (r / nb), n0 = 32 * (r % nb); p0_transpose_item(A.in[11], D, WSB(WS_WT_O), D, 0, n0, scr, k0, n0, F.lane); continue; } r -= I_O;
        if (r < I_C) { const int nb = D / 32, k0 = 64 * (r / nb), n0 = 32 * (r % nb); p0_transpose_item(A.in[9], D, WSB(WS_WT_M), D, 0, n0, scr, k0, n0, F.lane); continue; } r -= I_C;
        if (r < I_C) { const int nb = D / 32, k0 = 64 * (r / nb), n0 = 32 * (r % nb); p0_transpose_item(A.in[10], D, WSB(WS_WT_M), D, DC, n0, scr, k0, n0, F.lane); continue; } r -= I_C;
        if (r < I_G) { const int nb = D_FF / 32, k0 = 64 * (r / nb), n0 = 32 * (r % nb); p0_transpose_item(A.in[13], D_FF, WSB(WS_WT_GU), D, 0, pair_row(n0, 0), scr, k0, n0, F.lane); continue; } r -= I_G;
        if (r < I_G) { const int nb = D_FF / 32, k0 = 64 * (r / nb), n0 = 32 * (r % nb); p0_transpose_item(A.in[14], D_FF, WSB(WS_WT_GU), D, 0, pair_row(n0, 1), scr, k0, n0, F.lane); continue; } r -= I_G;
        if (r < I_G8) { const int nb = 4096 / 32, k0 = 64 * (r / nb), n0 = 7168 + 32 * (r % nb); p0_transpose_item_fp8(A.in[5], D_IN, A.ws + WS_WT8, D, win_dest_row(n0), scr, k0, n0, F.lane); continue; } r -= I_G8;
        { const int nb = 7168 / 32, k0 = 64 * (r / nb), n0 = 32 * (r % nb); p0_transpose_item(A.in[5], D_IN, WSB(WS_WT_IN), D, 0, win_dest_row(n0), scr, k0, n0, F.lane); }
    }
    if (fused) { __syncthreads(); phase1_rows(F, A); }
}

__device__ __forceinline__ void phase1_rows(Frame& F, const Args& A) {
    const float* x = A.in[0]; const float* g_mix = A.in[4]; const float* MOD = WSF(CTL_MOD); bf16_t* H = WSB(WS_H); unsigned char* H8 = A.ws + WS_H8;
    LAS float* PA = (LAS float*)(F.lds);
    LAS float* PB = (LAS float*)(F.lds + 32768);
    for (int i = F.tid; i < BATCH * D; i += NTHREADS) { const int b = i >> 11, col = i & (D - 1); const float* mb = MOD + (size_t)b * NMOD;
        PA[i] = g_mix[col] * (1.0f + mb[D + col]); PB[i] = mb[col]; }
    __syncthreads();
    const int gw = F.vcu * NWAVES + F.wave, NGW = F.G * NWAVES;
    for (int m = gw; m < M; m += NGW) {
        const int b = m >> 12; const f32x4* xr = (const f32x4*)(x + (size_t)m * D) + F.lane;
        f32x4 v[8]; float s = 0.f;
#pragma unroll
        for (int j = 0; j < 8; ++j) { v[j] = __builtin_nontemporal_load(xr + 64 * j); s += (v[j][0] * v[j][0] + v[j][1] * v[j][1]) + (v[j][2] * v[j][2] + v[j][3] * v[j][3]); }
        const float rstd = rsqrtf(wave_sum(s) * (1.0f / D) + EPS);
        u32x2* o8 = (u32x2*)(H + (size_t)m * D) + F.lane; unsigned* o4 = (unsigned*)(H8 + (size_t)m * D) + F.lane;
#pragma unroll
        for (int j = 0; j < 8; ++j) { const f32x4 a = *(const LAS f32x4*)(PA + b * D + 256 * j + 4 * F.lane), sh = *(const LAS f32x4*)(PB + b * D + 256 * j + 4 * F.lane);
            const f32x4 h = v[j] * rstd * a + sh; u32x2 w; w.x = cvt_pk_bf16(h[0], h[1]); w.y = cvt_pk_bf16(h[2], h[3]); o8[64 * j] = w; o4[64 * j] = pack4_fp8(h[0], h[1], h[2], h[3]); }
    }
}
__device__ __forceinline__ void phase_biasgu(Frame& F, const Args& A) {
    const float* MOD = WSF(CTL_MOD); float* BIASGU = WSF(CTL_BIASGU); const bf16_t* WT_GU = WSB(WS_WT_GU);
    LAS float* PS = (LAS float*)(F.lds + 65536);
    for (int i = F.tid; i < BATCH * D; i += NTHREADS) { const int b = i >> 11, col = i & (D - 1); PS[i] = MOD[(size_t)b * NMOD + 3 * D + col]; }
    __syncthreads();
    const int gw = F.vcu * NWAVES + F.wave, NGW = F.G * NWAVES;
    for (int n = gw; n < 2 * D_FF; n += NGW) {
        const u32x4* wr_ = (const u32x4*)(WT_GU + (size_t)n * D) + F.lane;
        float a[4] = {0.f, 0.f, 0.f, 0.f};
#pragma unroll
        for (int j = 0; j < 4; ++j) { const u32x4 w = wr_[64 * j]; f32x4 w0, w1; pg8::unpack8(w, w0, w1); const int k = 512 * j + 8 * F.lane;
#pragma unroll
            for (int b = 0; b < 4; ++b) { const f32x4 s0 = *(const LAS f32x4*)(PS + b * D + k), s1 = *(const LAS f32x4*)(PS + b * D + k + 4);
                a[b] += (w0[0] * s0[0] + w0[1] * s0[1]) + (w0[2] * s0[2] + w0[3] * s0[3]) + (w1[0] * s1[0] + w1[1] * s1[1]) + (w1[2] * s1[2] + w1[3] * s1[3]); } }
#pragma unroll
        for (int b = 0; b < 4; ++b) { const float t = wave_sum(a[b]); if (F.lane == 0) BIASGU[(size_t)b * (2 * D_FF) + n] = t; }
    }
    __syncthreads();
}
__device__ __forceinline__ void phase1(Frame& F, const Args& A) { phase1_rows(F, A); __syncthreads(); phase_biasgu(F, A); }

constexpr int RS = 272, RS_V = 272;
constexpr int SC_RAWSZ = 21632, SC_RAWL = 17408, SC_AIMG = 3 * SC_RAWSZ, SC_DEC = SC_AIMG + 2 * 2304;
struct ScanRegs { u32x4 v0, v1; u32x2 lf; };
__device__ __forceinline__ void scan_load(ScanRegs& R, const bf16_t* vg, const bf16_t* lg, int chunk, int tid) {
    const size_t r0 = (size_t)chunk * CHUNK;
    R.v0 = *(const u32x4*)(vg + (r0 + (tid >> 4)) * HV + (tid & 15) * 8);
    R.v1 = *(const u32x4*)(vg + (r0 + 32 + (tid >> 4)) * HV + (tid & 15) * 8);
    if (tid < 256) R.lf = *(const u32x2*)(lg + (r0 + (tid >> 2)) * HK + (tid & 3) * 4);
}
__device__ __forceinline__ void scan_write(const ScanRegs& R, LAS unsigned char* L, int slot, int tid) {
    LAS unsigned char* base = L + slot * SC_RAWSZ;
    *(LAS u32x4*)(base + (tid >> 4) * RS_V + (tid & 15) * 16) = R.v0;
    *(LAS u32x4*)(base + (32 + (tid >> 4)) * RS_V + (tid & 15) * 16) = R.v1;
    if (tid < 256) { const int t = tid >> 2, cq = tid & 3;
#pragma unroll
        for (int i = 0; i < 4; ++i) { const unsigned wv = (i < 2) ? R.lf.x : R.lf.y; *(LAS float*)(base + SC_RAWL + (4 * cq + i) * 264 + 4 * t) = __uint_as_float((i & 1) ? (wv & 0xffff0000u) : (wv << 16)); } }
}
#define DPP_SHR(x, n) __int_as_float(__builtin_amdgcn_update_dpp(0, __float_as_int(x), 0x110 | (n), 0xf, 0xf, true))
__device__ __forceinline__ f32x2 scan_aread(LAS unsigned char* L, int slot, int w, int lane) {
    return *(const LAS f32x2*)(L + slot * SC_RAWSZ + SC_RAWL + (2 * w + (lane >> 5)) * 264 + 8 * (lane & 31));
}
__device__ __forceinline__ void scan_apart(LAS unsigned char* L, const f32x2 lf, int p, int w, int lane) {
    const int c = 2 * w + (lane >> 5), tt = lane & 31; const bool hi = (lane & 32) != 0;
    float x = lf.x + lf.y;
    x += DPP_SHR(x, 1); x += DPP_SHR(x, 2); x += DPP_SHR(x, 4); x += DPP_SHR(x, 8);
    const float r0 = __int_as_float(__builtin_amdgcn_readlane(__float_as_int(x), 15)), r1 = __int_as_float(__builtin_amdgcn_readlane(__float_as_int(x), 47));
    if (lane & 16) x += hi ? r1 : r0;
    const float b0 = __int_as_float(__builtin_amdgcn_readlane(__float_as_int(x), 31)), b1 = __int_as_float(__builtin_amdgcn_readlane(__float_as_int(x), 63));
    const float blast = hi ? b1 : b0;
    const float bc1 = x, bc0 = x - lf.y;
    const float k0 = (1.0f - fast_exp(lf.x)) * fast_exp(blast - bc0), k1 = (1.0f - fast_exp(lf.y)) * fast_exp(blast - bc1);
    *(LAS unsigned*)(L + SC_AIMG + p * 2304 + c * 144 + 4 * tt) = cvt_pk_bf16(k0, k1);
    if (tt == 31) *(LAS float*)(L + SC_DEC + p * 64 + 4 * c) = fast_exp(blast);
}
__device__ __forceinline__ void scan_item(Frame& F, const bf16_t* LOGF, const bf16_t* V, bf16_t* SST, int item) {
    const int b = item >> 6, h = (item >> 3) & 7, ks = item & 7;
    const int tid = F.tid, lane = F.lane, w = F.wave, l15 = lane & 15, g = lane >> 4;
    LAS unsigned char* L = F.lds;
    const bf16_t* lg = LOGF + (size_t)(b * SEQ) * HK + h * 128 + ks * 16;
    const bf16_t* vg = V + (size_t)(b * SEQ) * HV + h * 128;
    bf16_t* sp = SST + ((size_t)((b * NH + h) * NCHUNK) * 128 + 16 * w + l15) * 128 + ks * 16 + 4 * g;
    ScanRegs R0, R1, R2, R3, R4, R5;
    R0.lf = (u32x2){0u, 0u}; R1.lf = R0.lf; R2.lf = R0.lf; R3.lf = R0.lf; R4.lf = R0.lf; R5.lf = R0.lf;
    scan_load(R4, vg, lg, 0, tid); scan_load(R5, vg, lg, 1, tid);
    scan_load(R0, vg, lg, 2, tid); scan_load(R1, vg, lg, 3, tid); scan_load(R2, vg, lg, 4, tid); scan_load(R3, vg, lg, 5, tid);
    scan_write(R4, L, 0, tid); scan_write(R5, L, 1, tid);
    scan_load(R4, vg, lg, 6, tid);
    __syncthreads();
    scan_apart(L, scan_aread(L, 0, w, lane), 0, w, lane);
    __syncthreads();
    f32x4 S = {0.f, 0.f, 0.f, 0.f};
    int n = 0, s0 = 0, s1 = 1, s2 = 2;
    const unsigned voff = (unsigned)((8 * g + (l15 >> 2)) * RS_V + 32 * w + 8 * (lane & 3));
#define SCAN_STEP(Ra, Rc) do { \
        scan_load(Rc, vg, lg, (n + 7 < NCHUNK ? n + 7 : NCHUNK - 1), tid); \
        { u32x2 wv; wv.x = cvt_pk_bf16(S[0], S[1]); wv.y = cvt_pk_bf16(S[2], S[3]); *(u32x2*)(sp + (size_t)n * 128 * 128) = wv; } \
        const f32x2 lfn = scan_aread(L, s1, w, lane); \
        { const int p = n & 1; const LAS unsigned char* ai = L + SC_AIMG + p * 2304 + l15 * 144 + 16 * g; \
          const bf16x8 A0 = *(const LAS bf16x8*)ai, A1 = *(const LAS bf16x8*)(ai + 64); \
          const f32x4 dec = *(const LAS f32x4*)(L + SC_DEC + p * 64 + 16 * g); \
          const unsigned vb = (unsigned)(uintptr_t)(L + s0 * SC_RAWSZ) + voff; \
          u32x2 t00, t01, t10, t11; \
          asm volatile("ds_read_b64_tr_b16 %0, %4\n\tds_read_b64_tr_b16 %1, %4 offset:1088\n\tds_read_b64_tr_b16 %2, %4 offset:8704\n\tds_read_b64_tr_b16 %3, %4 offset:9792\n\ts_waitcnt lgkmcnt(0)" \
                       : "=&v"(t00), "=&v"(t01), "=&v"(t10), "=&v"(t11) : "v"(vb) : "memory"); \
          const u32x4 q0 = {t00.x, t00.y, t01.x, t01.y}, q1 = {t10.x, t10.y, t11.x, t11.y}; \
          f32x4 Cin = S * dec; \
          Cin = __builtin_amdgcn_mfma_f32_16x16x32_bf16(A0, __builtin_bit_cast(bf16x8, q0), Cin, 0, 0, 0); \
          S = __builtin_amdgcn_mfma_f32_16x16x32_bf16(A1, __builtin_bit_cast(bf16x8, q1), Cin, 0, 0, 0); } \
        scan_apart(L, lfn, (n + 1) & 1, w, lane); \
        scan_write(Ra, L, s2, tid); \
        __syncthreads(); \
        { const int t_ = s0; s0 = s1; s1 = s2; s2 = t_; ++n; } } while (0)
    for (int it = 0; it < 10; ++it) { SCAN_STEP(R0, R5); SCAN_STEP(R1, R0); SCAN_STEP(R2, R1); SCAN_STEP(R3, R2); SCAN_STEP(R4, R3); SCAN_STEP(R5, R4); }
    SCAN_STEP(R0, R5); SCAN_STEP(R1, R0); SCAN_STEP(R2, R1);
#undef SCAN_STEP
    { u32x2 wv; wv.x = cvt_pk_bf16(S[0], S[1]); wv.y = cvt_pk_bf16(S[2], S[3]); *(u32x2*)(sp + (size_t)n * 128 * 128) = wv; }
    __syncthreads();
}
__device__ __forceinline__ void phase3a(Frame& F, const Args& A) {
    for (int it = F.vcu; it < BATCH * NH * 8; it += F.G) scan_item(F, WSB(WS_LOGF), WSB(WS_V), WSB(WS_H), it);
}

constexpr int L_QT = 0, L_KB = 17408, L_VS = 34816, L_QA = 52224, L_SC = 95744, L_TOT = 104960, L_RR = 107008, L_SSQ = 109056, SCS = 144;
struct OutPtrs { const bf16_t* LOGF; const bf16_t *Q, *V, *GO, *SST; const float* gnorm; bf16_t* ZO; const bf16_t *U, *AB; const float* conv_w; };
struct OutRegs { f32x2 lf[8]; unsigned qq[8]; u32x4 vv[2]; bf16x8 SA[4]; u32x4 cu0[2], cu1[2], cu2[2], cab[2]; u32x2 go[4]; };
__device__ __forceinline__ void out_ld1(OutRegs& R, const OutPtrs& P, int item, int tid, int lane, int w) {
    const int b = item >> 9, h = (item >> 6) & 7, n = item & 63; const size_t row0 = (size_t)b * SEQ + (size_t)n * CHUNK;
    const bf16_t* lfp = P.LOGF + (row0 + 8 * w) * HK + h * 128 + 2 * lane; const bf16_t* qp = P.Q + (row0 + 8 * w) * HK + h * 128 + 2 * lane;
#pragma unroll
    for (int i = 0; i < 8; ++i) { const unsigned lw = *(const unsigned*)(lfp + (size_t)i * HK); R.lf[i] = (f32x2){__uint_as_float(lw << 16), __uint_as_float(lw & 0xffff0000u)}; R.qq[i] = *(const unsigned*)(qp + (size_t)i * HK); }
#pragma unroll
    for (int j = 0; j < 2; ++j) { const int id = tid + 512 * j, r = id >> 4, ch = id & 15; R.vv[j] = *(const u32x4*)(P.V + (row0 + r) * HV + h * 128 + ch * 8); }
}
__device__ __forceinline__ void out_ldS(OutRegs& R, const OutPtrs& P, int item, int lane, int w) {
    const bf16_t* sp = P.SST + ((size_t)item * 128 + 16 * w + (lane & 15)) * 128 + 8 * (lane >> 4);
#pragma unroll
    for (int ks = 0; ks < 4; ++ks) R.SA[ks] = *(const bf16x8*)(sp + 32 * ks);
}
__device__ __forceinline__ void out_ldC(OutRegs& R, const OutPtrs& P, int item, int tid) {
    const int b = item >> 9, h = (item >> 6) & 7, n = item & 63; const size_t row0 = (size_t)b * SEQ + (size_t)n * CHUNK; const u32x4 z4 = {0u, 0u, 0u, 0u};
#pragma unroll
    for (int j = 0; j < 2; ++j) { const int r = (tid >> 4) + 32 * j, t = n * CHUNK + r; const size_t o = (row0 + r) * DC + h * 128 + (tid & 15) * 8;
        R.cu2[j] = *(const u32x4*)(P.U + o); R.cu1[j] = t >= 1 ? *(const u32x4*)(P.U + o - DC) : z4; R.cu0[j] = t >= 2 ? *(const u32x4*)(P.U + o - 2 * DC) : z4; R.cab[j] = *(const u32x4*)(P.AB + o); }
}
__device__ __forceinline__ void out_ldG(OutRegs& R, const OutPtrs& P, int item, int lane, int w) {
    const int b = item >> 9, h = (item >> 6) & 7, n = item & 63; const size_t row0 = (size_t)b * SEQ + (size_t)n * CHUNK;
#pragma unroll
    for (int tb = 0; tb < 4; ++tb) R.go[tb] = *(const u32x2*)(P.GO + (row0 + 16 * tb + (lane & 15)) * HV + h * 128 + 16 * w + 4 * (lane >> 4));
}
__device__ __forceinline__ void out_items(Frame& F, const OutPtrs& P, int first, int count, int stride) {
    const int tid = F.tid, lane = F.lane, w = F.wave, l15 = lane & 15, g = lane >> 4;
    LAS unsigned char* L = F.lds;
    if (count <= 0) return;
    OutRegs R;
    out_ld1(R, P, first, tid, lane, w); out_ldC(R, P, first, tid); out_ldS(R, P, first, lane, w); out_ldG(R, P, first, lane, w);
    const f32x4 gn = *(const f32x4*)(P.gnorm + 16 * w + 4 * g);
    int hc = (first >> 6) & 7; f32x4 cw0[2], cw1[2], cw2[2];
    { const int c8 = hc * 128 + (tid & 15) * 8;
#pragma unroll
      for (int qq2 = 0; qq2 < 2; ++qq2) { cw0[qq2] = *(const f32x4*)(P.conv_w + c8 + 4 * qq2); cw1[qq2] = *(const f32x4*)(P.conv_w + DC + c8 + 4 * qq2); cw2[qq2] = *(const f32x4*)(P.conv_w + 2 * DC + c8 + 4 * qq2); } }
    for (int q = 0; q < count; ++q) {
    const int item = first + q * stride, nitem = item + stride; const bool more = (q + 1 < count);
    const int b = item >> 9, h = (item >> 6) & 7, n = item & 63;
    if (h != hc) { hc = h; const int c8 = h * 128 + (tid & 15) * 8;
#pragma unroll
      for (int qq2 = 0; qq2 < 2; ++qq2) { cw0[qq2] = *(const f32x4*)(P.conv_w + c8 + 4 * qq2); cw1[qq2] = *(const f32x4*)(P.conv_w + DC + c8 + 4 * qq2); cw2[qq2] = *(const f32x4*)(P.conv_w + 2 * DC + c8 + 4 * qq2); } }
    const size_t row0 = (size_t)b * SEQ + (size_t)n * CHUNK;
    {
#pragma unroll
      for (int j = 0; j < 2; ++j) { const int id = tid + 512 * j, r = id >> 4, ch = id & 15; *(LAS u32x4*)(L + L_VS + r * RS + ch * 16) = R.vv[j]; }
      f32x2 bc[8]; f32x2 run = {0.f, 0.f};
#pragma unroll
      for (int i = 0; i < 8; ++i) { run += R.lf[i]; bc[i] = run; }
      *(LAS f32x2*)(L + L_TOT + (w * 128 + 2 * lane) * 4) = run;
      __syncthreads();
      f32x2 off = {0.f, 0.f}, rown = {0.f, 0.f}, rj[3] = {{0.f, 0.f}, {0.f, 0.f}, {0.f, 0.f}}; const int tb = w >> 1;
      { f32x2 pacc = {0.f, 0.f};
#pragma unroll
        for (int j = 0; j < 8; ++j) { pacc += *(const LAS f32x2*)(L + L_TOT + (j * 128 + 2 * lane) * 4);
            if (j < w) off = pacc;
            if ((j & 1) == 0) { if (j == 2 * tb) rown = pacc; if ((j >> 1) < 3 && (j >> 1) < tb) rj[j >> 1] = pacc; } } }
      const f32x2 er = {fast_exp(rown.x), fast_exp(rown.y)};
      f32x2 ej[3];
#pragma unroll
      for (int j = 0; j < 3; ++j) { ej[j].x = fast_exp(rown.x - rj[j].x); ej[j].y = fast_exp(rown.y - rj[j].y); }
      const int pd = tb * (tb + 1) / 2 + tb, rb = 8 * (w & 1);
#pragma unroll
      for (int i = 0; i < 8; ++i) { const int t = 8 * w + i;
          const f32x2 bb = bc[i] + off; const f32x2 qv = {__uint_as_float(R.qq[i] << 16), __uint_as_float(R.qq[i] & 0xffff0000u)};
          const f32x2 E = {fast_exp(bb.x - rown.x), fast_exp(bb.y - rown.y)}; const f32x2 Ei = {fast_rcp(E.x), fast_rcp(E.y)};
          const f32x2 kk = {1.0f - fast_exp(R.lf[i].x), 1.0f - fast_exp(R.lf[i].y)};
          const f32x2 qe = qv * E;
          *(LAS unsigned*)(L + L_QT + t * RS + 4 * lane) = cvt_pk_bf16(qe.x * er.x, qe.y * er.y);
          *(LAS unsigned*)(L + L_KB + t * RS + 4 * lane) = cvt_pk_bf16(kk.x * Ei.x, kk.y * Ei.y);
          *(LAS unsigned*)(L + L_QA + (pd * 16 + rb + i) * RS + 4 * lane) = cvt_pk_bf16(qe.x, qe.y);
#pragma unroll
          for (int j = 0; j < 3; ++j) if (j < tb) *(LAS unsigned*)(L + L_QA + ((tb * (tb + 1) / 2 + j) * 16 + rb + i) * RS + 4 * lane) = cvt_pk_bf16(qe.x * ej[j].x, qe.y * ej[j].y); }
      if (more) out_ld1(R, P, nitem, tid, lane, w);
      { const int c8 = h * 128 + (tid & 15) * 8;
#pragma unroll
        for (int j = 0; j < 2; ++j) { const int r = (tid >> 4) + 32 * j;
            f32x4 a0, a1, b0, b1, c0, c1, d0, d1; pg8::unpack8(R.cu0[j], a0, a1); pg8::unpack8(R.cu1[j], b0, b1); pg8::unpack8(R.cu2[j], c0, c1); pg8::unpack8(R.cab[j], d0, d1);
            const f32x4 z0 = d0 * (cw0[0] * a0 + cw1[0] * b0 + cw2[0] * c0), z1 = d1 * (cw0[1] * a1 + cw1[1] * b1 + cw2[1] * c1);
            *(u32x4*)(P.ZO + (row0 + r) * D + c8) = pg8::pack8(z0, z1); } }
      if (more) out_ldC(R, P, nitem, tid);
      __syncthreads(); }
    for (int p = w; p < 10; p += 8) {
        const int i = p < 1 ? 0 : (p < 3 ? 1 : (p < 6 ? 2 : 3)), j = p - i * (i + 1) / 2;
        f32x4 a = {0.f, 0.f, 0.f, 0.f};
#pragma unroll
        for (int ks = 0; ks < 4; ++ks) { const bf16x8 ka = *(const LAS bf16x8*)(L + L_KB + (16 * j + l15) * RS + 64 * ks + 16 * g), qb = *(const LAS bf16x8*)(L + L_QA + (p * 16 + l15) * RS + 64 * ks + 16 * g);
            a = __builtin_amdgcn_mfma_f32_16x16x32_bf16(ka, qb, a, 0, 0, 0); }
        if (i == j) {
#pragma unroll
            for (int r = 0; r < 4; ++r) if (4 * g + r > l15) a[r] = 0.f; }
        u32x2 wv; wv.x = cvt_pk_bf16(a[0], a[1]); wv.y = cvt_pk_bf16(a[2], a[3]);
        *(LAS u32x2*)(L + L_SC + (16 * i + l15) * SCS + (16 * j + 4 * g) * 2) = wv;
    }
    if (w == 2 || w == 3) { const int i = (w == 2) ? 0 : 2, j = i + 1; const u32x2 z = {0u, 0u}; *(LAS u32x2*)(L + L_SC + (16 * i + l15) * SCS + (16 * j + 4 * g) * 2) = z; }
    __syncthreads();
    f32x4 o[4];
#pragma unroll
    for (int tb = 0; tb < 4; ++tb) { o[tb] = (f32x4){0.f, 0.f, 0.f, 0.f};
#pragma unroll
        for (int ks = 0; ks < 4; ++ks) { const bf16x8 qb = *(const LAS bf16x8*)(L + L_QT + (16 * tb + l15) * RS + 64 * ks + 16 * g);
            o[tb] = __builtin_amdgcn_mfma_f32_16x16x32_bf16(R.SA[ks], qb, o[tb], 0, 0, 0); } }
    if (more) out_ldS(R, P, nitem, lane, w);
    {
      const unsigned vb = (unsigned)(uintptr_t)(L + L_VS) + (unsigned)((8 * g + (l15 >> 2)) * RS + 32 * w + 8 * (lane & 3));
      u32x2 t00, t01, t10, t11;
      asm volatile("ds_read_b64_tr_b16 %0, %4\n\tds_read_b64_tr_b16 %1, %4 offset:1088\n\tds_read_b64_tr_b16 %2, %4 offset:8704\n\tds_read_b64_tr_b16 %3, %4 offset:9792\n\ts_waitcnt lgkmcnt(0)"
                   : "=&v"(t00), "=&v"(t01), "=&v"(t10), "=&v"(t11) : "v"(vb) : "memory");
      bf16x8 VA0, VA1;
      { u32x4 q0 = {t00.x, t00.y, t01.x, t01.y}, q1 = {t10.x, t10.y, t11.x, t11.y}; VA0 = __builtin_bit_cast(bf16x8, q0); VA1 = __builtin_bit_cast(bf16x8, q1); }
#pragma unroll
      for (int tb = 0; tb < 4; ++tb) { const bf16x8 s0 = *(const LAS bf16x8*)(L + L_SC + (16 * tb + l15) * SCS + 16 * g);
          o[tb] = __builtin_amdgcn_mfma_f32_16x16x32_bf16(VA0, s0, o[tb], 0, 0, 0);
          if (tb >= 2) { const bf16x8 s1 = *(const LAS bf16x8*)(L + L_SC + (16 * tb + l15) * SCS + 64 + 16 * g); o[tb] = __builtin_amdgcn_mfma_f32_16x16x32_bf16(VA1, s1, o[tb], 0, 0, 0); } } }
#pragma unroll
    for (int tb = 0; tb < 4; ++tb) { float s = (o[tb][0] * o[tb][0] + o[tb][1] * o[tb][1]) + (o[tb][2] * o[tb][2] + o[tb][3] * o[tb][3]);
        s += __shfl_xor(s, 16); s += __shfl_xor(s, 32);
        if (g == 0) ((LAS float*)(L + L_SSQ))[(16 * tb + l15) * 8 + w] = s; }
    __syncthreads();
    const u32x2 gcur[4] = {R.go[0], R.go[1], R.go[2], R.go[3]};
    if (more) out_ldG(R, P, nitem, lane, w);
#pragma unroll
    for (int tb = 0; tb < 4; ++tb) { const int t = 16 * tb + l15;
        const f32x4 s0 = *(const LAS f32x4*)(L + L_SSQ + t * 32), s1 = *(const LAS f32x4*)(L + L_SSQ + t * 32 + 16);
        const float rstd = rsqrtf(((s0[0] + s0[1]) + (s0[2] + s0[3]) + (s1[0] + s1[1]) + (s1[2] + s1[3])) * (1.0f / 128.0f) + EPS);
        const u32x2 gv = gcur[tb];
        const float g0 = __uint_as_float(gv.x << 16), g1 = __uint_as_float(gv.x & 0xffff0000u), g2 = __uint_as_float(gv.y << 16), g3 = __uint_as_float(gv.y & 0xffff0000u);
        u32x2 wv; wv.x = cvt_pk_bf16(o[tb][0] * rstd * gn[0] * g0, o[tb][1] * rstd * gn[1] * g1); wv.y = cvt_pk_bf16(o[tb][2] * rstd * gn[2] * g2, o[tb][3] * rstd * gn[3] * g3);
        *(u32x2*)(P.ZO + (row0 + t) * D + DC + h * 128 + 16 * w + 4 * g) = wv; }
    }
    __syncthreads();
}
__device__ __forceinline__ void phase3b(Frame& F, const Args& A) {
    const OutPtrs P{WSB(WS_LOGF), WSB(WS_Q), WSB(WS_V), WSB(WS_G), WSB(WS_H), A.in[8], WSB(WS_ZO), WSB(WS_U), WSB(WS_AB), A.in[6]};
    const int total = BATCH * NH * NCHUNK;
    out_items(F, P, F.vcu, F.vcu < total ? (total - F.vcu + F.G - 1) / F.G : 0, F.G);
}
__device__ __forceinline__ void phase3ab_fused(Frame& F, const Args& A) {
    const int item = F.vcu;
    scan_item(F, WSB(WS_LOGF), WSB(WS_V), WSB(WS_H), item);
    asm volatile("s_waitcnt vmcnt(0)" ::: "memory");
    __syncthreads();
    if (F.tid == 0) { unsigned* cw = (unsigned*)A.ws + CW_HEAD + 64 * (item >> 3);
        __builtin_amdgcn_fence(__ATOMIC_RELEASE, "agent"); asm volatile("s_waitcnt vmcnt(0)" ::: "memory");
        __hip_atomic_fetch_add(cw, 1u, __ATOMIC_RELAXED, __HIP_MEMORY_SCOPE_AGENT);
        __builtin_amdgcn_fence(__ATOMIC_ACQUIRE, "agent");
        unsigned sp = 0;
        while (__hip_atomic_load(cw, __ATOMIC_RELAXED, __HIP_MEMORY_SCOPE_AGENT) < 8u) { __builtin_amdgcn_s_sleep(2); if (++sp > (1u << 22)) break; }
        asm volatile("s_waitcnt vmcnt(0)" ::: "memory"); }
    __syncthreads();
    const OutPtrs P{WSB(WS_LOGF), WSB(WS_Q), WSB(WS_V), WSB(WS_G), WSB(WS_H), A.in[8], WSB(WS_ZO), WSB(WS_U), WSB(WS_AB), A.in[6]};
    const int bh = item >> 3, ks = item & 7;
#ifdef PROBE_P3X
    for (int rep = 0; rep <= PROBE_P3X; ++rep) { __syncthreads(); out_items(F, P, bh * NCHUNK + ks * 8, 8, 1); }
#else
    out_items(F, P, bh * NCHUNK + ks * 8, 8, 1);
#endif
}

__device__ __forceinline__ void phase8(Frame& F, const Args& A) {
    const float* g_final = A.in[16]; const float* RSS2 = WSF(CTL_RSS2); float* out = A.out;
    const int gw = F.vcu * NWAVES + F.wave, NGW = F.G * NWAVES;
    f32x4 gf[8];
#pragma unroll
    for (int j = 0; j < 8; ++j) gf[j] = *((const f32x4*)g_final + F.lane + 64 * j);
    for (int m = gw; m < M; m += NGW) {
        const float rstd = rsqrtf(RSS2[m] * (1.0f / D) + EPS);
        f32x4* xr = (f32x4*)(out + (size_t)m * D) + F.lane;
#pragma unroll
        for (int j = 0; j < 8; ++j) xr[64 * j] = xr[64 * j] * rstd * gf[j];
    }
}

#define XB_TMO      128
#define XB_XCNT(j)  (256  + 64 * (j))
#define XB_XSUB(j)  (1280 + 64 * (j))
#define XB_XGEN(j)  (2304 + 64 * (j))
#define XB_TOP      3328
#define XB_TOPGEN   3392
#define XCD_BAR_WORDS 3456
#define XB_SPIN_CAP (1u << 18)
__device__ __forceinline__ unsigned xb_ld(unsigned* p)              { return __hip_atomic_load(p, __ATOMIC_RELAXED, __HIP_MEMORY_SCOPE_AGENT); }
__device__ __forceinline__ unsigned xb_add(unsigned* p, unsigned v) { return __hip_atomic_fetch_add(p, v, __ATOMIC_RELAXED, __HIP_MEMORY_SCOPE_AGENT); }
__device__ __forceinline__ unsigned xb_xcc_id() { return (unsigned)__builtin_amdgcn_s_getreg((3 << 11) | 20) & 0xFu; }
#define XB_SPIN(cond, bar) do { unsigned _sp = 0; while (cond) { __builtin_amdgcn_s_sleep(1); \
    if ((++_sp & 255u) == 0u) { if (xb_ld(&(bar)[XB_TMO])) break; if (_sp > XB_SPIN_CAP) { atomicAdd(&(bar)[XB_TMO], 1u); break; } } } } while (0)
struct XcdBarrier { unsigned* bar; unsigned x; volatile LAS unsigned* st; };
__device__ __forceinline__ XcdBarrier xcd_barrier_post(unsigned* bar, volatile LAS unsigned* st) {
    XcdBarrier b; b.bar = bar; b.x = xb_xcc_id(); b.st = st;
    if (threadIdx.x == 0) (void)xb_add(&bar[XB_XCNT(b.x)], 1u);
    return b;
}
__device__ __forceinline__ void xcd_barrier_complete(unsigned* bar, unsigned x, unsigned& nloc, unsigned& nx) {
    const unsigned G = gridDim.x * gridDim.y * gridDim.z;
    unsigned sum, cnt, mine, sp = 0u;
    for (;;) {
        sum = 0u; cnt = 0u; mine = 0u;
#pragma unroll
        for (unsigned j = 0; j < 16; ++j) { const unsigned c = xb_ld(&bar[XB_XCNT(j)]); sum += c; cnt += (c > 0u) ? 1u : 0u; mine = (j == x) ? c : mine; }
        if (sum == G) break;
        __builtin_amdgcn_s_sleep(1);
        if ((++sp & 255u) == 0u) { if (xb_ld(&bar[XB_TMO])) break; if (sp > XB_SPIN_CAP) { atomicAdd(&bar[XB_TMO], 1u); break; } }
    }
    nloc = mine > 0u ? mine : 1u; nx = cnt > 0u ? cnt : 1u;
}
__device__ __forceinline__ void xcd_barrier(const XcdBarrier& b) {
    asm volatile("s_waitcnt vmcnt(0)" ::: "memory");
    __syncthreads();
    if (threadIdx.x == 0) {
        unsigned* bar = b.bar;
        __builtin_amdgcn_s_waitcnt(0);
        unsigned nloc = b.st[0], nx = b.st[1];
        if (nloc == 0u) { xcd_barrier_complete(bar, b.x, nloc, nx); b.st[0] = nloc; b.st[1] = nx; }
        const unsigned old = xb_add(&bar[XB_XSUB(b.x)], 1u);
        const unsigned gen = old / nloc;
        if (old + 1u == (gen + 1u) * nloc) {
            __builtin_amdgcn_fence(__ATOMIC_RELEASE, "agent");
            asm volatile("s_waitcnt vmcnt(0)" ::: "memory");
            __builtin_amdgcn_fence(__ATOMIC_ACQUIRE, "agent");
            const unsigned og = xb_add(&bar[XB_TOP], 1u);
            const unsigned tg = og / nx;
            if (og + 1u == (tg + 1u) * nx) xb_add(&bar[XB_TOPGEN], 1u);
            else XB_SPIN(xb_ld(&bar[XB_TOPGEN]) == tg, bar);
            xb_add(&bar[XB_XGEN(b.x)], 1u);
            asm volatile("s_waitcnt vmcnt(0)" ::: "memory");
        } else {
            __builtin_amdgcn_fence(__ATOMIC_ACQUIRE, "agent");
            XB_SPIN(xb_ld(&bar[XB_XGEN(b.x)]) == gen, bar);
            asm volatile("s_waitcnt vmcnt(0)" ::: "memory");
        }
    }
    __syncthreads();
}
#ifndef MK_USE_CG
#define MK_USE_CG 0
#endif
#if MK_USE_CG
#define GRID_SETUP() do {} while (0)
#define GRID_SYNC() cg::this_grid().sync()
#else
#define GRID_SETUP() volatile LAS unsigned* xb_st = (volatile LAS unsigned*)(F.lds + MISC_OFF); \
    if (F.tid < 2) xb_st[F.tid] = 0u; __syncthreads(); \
    XcdBarrier xbar; xbar.bar = (unsigned*)A.ws + CW_BAR; xbar.x = 0; xbar.st = xb_st; \
    if (hi - lo > 1) xbar = xcd_barrier_post((unsigned*)A.ws + CW_BAR, xb_st)
#define GRID_SYNC() xcd_barrier(xbar)
#endif

__global__ void __launch_bounds__(NTHREADS, 2) fwd_kernel(Args A) {
    extern __shared__ __attribute__((aligned(16))) unsigned char lds_raw[];
    Frame F;
    F.lds = (LAS unsigned char*)lds_raw;
    F.tid = threadIdx.x; F.lane = F.tid & 63; F.wave = __builtin_amdgcn_readfirstlane(F.tid >> 6);
    F.G = gridDim.x; { const int bx = blockIdx.x; F.vcu = (F.G % 8 == 0) ? (bx % 8) * (F.G / 8) + bx / 8 : bx; }
    const int lo = A.ph_lo, hi = A.ph_hi;
#define IN(k) (lo <= (k) && (k) < hi)
#define SEAM(k) do { if (IN(k) && IN((k) + 1)) { GRID_SYNC(); } } while (0)
    GRID_SETUP();
    const bool fuse01 = IN(0) && IN(1) && F.G == 256 && PROBE_DUP != 0 && PROBE_DUP != 1;
    if (fuse01) { phase0(F, A, 1.0f, true); SEAM(1); }
    else {
    if (IN(0)) { phase0(F, A, 1.0f, false); if (PROBE_DUP == 0) { __syncthreads(); phase0(F, A, 0.0f, false); } } SEAM(0);
    if (IN(1)) { phase1(F, A); if (PROBE_DUP == 1) { __syncthreads(); phase1(F, A); } } SEAM(1);
    }
    if (IN(2)) {
        {
          pg8::Gemm g{(const bf16_t*)(A.ws + WS_H8), (const bf16_t*)(A.ws + WS_WT8), M, 4096, D / 2}; pg8::StaticOrder S; S.init(M, 4096, F.G, (int)blockIdx.x);
          pg8::EpiIn<true> E{WSB(WS_AB), WSB(WS_U), WSB(WS_Q), WSB(WS_V), WSB(WS_G), (unsigned char*)A.out, (unsigned char*)A.out + (size_t)M * D, WSB(WS_LOGF), WSF(CTL_LB), 0, 1.0f / 64.0f};
          pg8::gemm_phase<pg8::EpiIn<true>, true, true, true>(F.lds, g, S, E); }
        {
          pg8::Gemm g{WSB(WS_H), WSB(WS_WT_IN) + (size_t)4096 * D, M, 7168, D}; pg8::StaticOrder S; S.init(M, 7168, F.G, (int)blockIdx.x);
          pg8::EpiIn<false> E{WSB(WS_AB), WSB(WS_U), WSB(WS_Q), WSB(WS_V), WSB(WS_G), (unsigned char*)A.out, (unsigned char*)A.out + (size_t)M * D, WSB(WS_LOGF), WSF(CTL_LB), 16, 1.0f};
          pg8::gemm_phase<pg8::EpiIn<false>, true, true>(F.lds, g, S, E); }
    } SEAM(2);
    if (IN(3) && IN(4) && F.G == 256 && PROBE_DUP != 3 && PROBE_DUP != 4) { phase3ab_fused(F, A); SEAM(4); }
    else {
    if (IN(3)) { phase3a(F, A); if (PROBE_DUP == 3) phase3a(F, A); } SEAM(3);
    if (IN(4)) { phase3b(F, A); if (PROBE_DUP == 4) phase3b(F, A); } SEAM(4);
    }
    if (IN(5)) { pg8::Gemm g{WSB(WS_ZO), WSB(WS_WT_M), M, D, D}; pg8::StaticOrder S; S.init(M, D, F.G, (int)blockIdx.x);
        pg8::EpiMerge E{(const unsigned char*)A.out, (const unsigned char*)A.out + (size_t)M * D, WSB(WS_H)};
        pg8::gemm_phase<pg8::EpiMerge, true, true>(F.lds, g, S, E); if (PROBE_DUP == 5) pg8::gemm_phase<pg8::EpiMerge, true, true>(F.lds, g, S, E); } SEAM(5);
    if (IN(6)) { pg8::Gemm g{WSB(WS_H), WSB(WS_WT_O), M, D, D}; pg8::StaticOrder S; S.init(M, D, F.G, (int)blockIdx.x);
        pg8::EpiWo E{A.in[0], WSF(CTL_MOD), A.in[12], WSB(WS_X1), WSB(WS_X1), WSF(CTL_RSS1), 1.0f};
        pg8::gemm_phase<pg8::EpiWo, true, true>(F.lds, g, S, E);
        if (PROBE_DUP == 6) { pg8::EpiWo E2 = E; E2.amul = 0.0f; pg8::gemm_phase<pg8::EpiWo, true, true>(F.lds, g, S, E2); } } SEAM(6);
    if (IN(7)) { pg8::Gemm g{WSB(WS_X1), WSB(WS_WT_GU), M, 2 * D_FF, D}; pg8::StaticOrder S; S.init(M, 2 * D_FF, F.G, (int)blockIdx.x);
        pg8::EpiFfn E{WSF(CTL_RSS1), WSF(CTL_BIASGU), WSB(WS_ACT)};
        pg8::gemm_phase<pg8::EpiFfn, true, true>(F.lds, g, S, E); if (PROBE_DUP == 7) pg8::gemm_phase<pg8::EpiFfn, true, true>(F.lds, g, S, E); } SEAM(7);
    const int fuse_norm = (F.G == 256) && (PROBE_DUP != 8);
    if (IN(8)) { pg8::Gemm g{WSB(WS_ACT), WSB(WS_WT_D), M, D, D_FF}; pg8::StaticOrder S; S.init(M, D, F.G, (int)blockIdx.x);
        pg8::EpiDown E{WSB(WS_X1), WSF(CTL_MOD), A.in[16], A.out, WSF(CTL_RSS2), (unsigned*)A.ws + CW_PANEL, 1.0f, fuse_norm, A.in[12]};
        pg8::gemm_phase<pg8::EpiDown, true, true>(F.lds, g, S, E);
        if (PROBE_DUP == 8) { pg8::EpiDown E2 = E; E2.amul = 0.0f; pg8::gemm_phase<pg8::EpiDown, true, true>(F.lds, g, S, E2); } }
    if (!fuse_norm) { SEAM(8); if (IN(9)) { phase8(F, A); } }
#undef IN
#undef SEAM
}

constexpr int NPHASES = 10;
extern "C" void kernel_launch(void* const* d_in, const int* in_sizes, int n_in, void* d_out, int out_size, void* d_ws, size_t ws_size, hipStream_t stream) {
    static int grid = 0;
    if (grid == 0) {
        if (n_in != 17 || in_sizes[0] != M * D || out_size != M * D || ws_size < WS_END) { fprintf(stderr, "kernel_launch: unexpected shapes (n_in %d, in0 %d, out %d, ws %zu)\n", n_in, n_in > 0 ? in_sizes[0] : -1, out_size, ws_size); grid = -1; return; }
        int dev = 0, cus = 0, per_cu = 0;
        if (hipGetDevice(&dev) != hipSuccess || hipDeviceGetAttribute(&cus, hipDeviceAttributeMultiprocessorCount, dev) != hipSuccess) { grid = -1; return; }
        if (hipFuncSetAttribute((const void*)fwd_kernel, hipFuncAttributeMaxDynamicSharedMemorySize, LDS_BYTES) != hipSuccess) { fprintf(stderr, "kernel_launch: hipFuncSetAttribute failed\n"); grid = -1; return; }
        if (hipOccupancyMaxActiveBlocksPerMultiprocessor(&per_cu, (const void*)fwd_kernel, NTHREADS, LDS_BYTES) != hipSuccess || per_cu < 1) { fprintf(stderr, "kernel_launch: occupancy query says %d\n", per_cu); (void)hipGetLastError(); grid = -1; return; }
        grid = cus;
    }
    if (grid < 0) return;
    (void)hipMemsetAsync((char*)d_ws + WS_CTL, 0, CTL_BIASGU + (size_t)BATCH * 2 * D_FF * sizeof(float), stream);
    Args a{};
    for (int i = 0; i < 17; ++i) a.in[i] = (const float*)d_in[i];
    a.out = (float*)d_out; a.ws = (unsigned char*)d_ws;
    if (MK_N_LAUNCHES == 1) {
        a.ph_lo = 0; a.ph_hi = NPHASES;
        void* kargs[] = {&a};
        hipError_t e = hipLaunchCooperativeKernel((const void*)fwd_kernel, dim3(grid), dim3(NTHREADS), kargs, LDS_BYTES, stream);
        if (e != hipSuccess) fprintf(stderr, "kernel_launch: cooperative launch failed: %s (grid %d)\n", hipGetErrorString(e), grid);
    } else {
        for (int p = 0; p < NPHASES; ++p) { a.ph_lo = p; a.ph_hi = p + 1; hipLaunchKernelGGL(fwd_kernel, dim3(grid), dim3(NTHREADS), LDS_BYTES, stream, a); }
    }
}
```
